# Optimizing an MI355X kernel written in HIP

```python
import jax, jax.numpy as jnp
from jax import lax
import numpy as np

D_MODEL = 1024
BATCH = 16
SEQ = 2048
DEPTH = 1

CHUNK = 128
SGU_WIDTH = 1024
SGU_GROUPS = 8
SGU_GROUP_DIM = SGU_WIDTH // SGU_GROUPS
ATT_HEADS = 8
ATT_HEAD_DIM = 128
ATT_WIDTH = ATT_HEADS * ATT_HEAD_DIM
DILATED_PATTERNS = ((128, 1), (512, 4), (2048, 16))
IN_WIDTH = 2 * SGU_WIDTH + 3 * ATT_WIDTH + 2 * D_MODEL
N_GROUPS = 4
EXPERTS_PER_GROUP = 4
N_EXPERTS = N_GROUPS * EXPERTS_PER_GROUP
TOP_K_EXPERTS = 2
D_EXPERT = 512
EPS = 1e-6
NEG_INF = -1e30

kernel_name = "hybrid_gmlp_dilated_attn_hmoe_block"


def _rmsnorm(x, g):
    xf = x.astype(jnp.float32)
    y = xf * lax.rsqrt(jnp.mean(xf * xf, axis=-1, keepdims=True) + EPS)
    return (y * g.astype(jnp.float32)).astype(x.dtype)


def _modulate(h, shift, scale):
    return h * (1 + scale[:, None, :]) + shift[:, None, :]


def _spatial_gating(u, v, norm_g, w_s, b_s):
    B, S, _ = v.shape
    v = _rmsnorm(v, norm_g)
    vc = v.reshape(B, S // CHUNK, CHUNK, SGU_GROUPS, SGU_GROUP_DIM)
    causal = jnp.tril(jnp.ones((CHUNK, CHUNK), dtype=bool))
    w = jnp.where(causal[None], w_s, 0)
    mixed = jnp.einsum('gts,bcsgk->bctgk', w, vc) + b_s.T[None, None, :, :, None]
    return u * mixed.reshape(B, S, SGU_WIDTH)


def _dilated_window_attention(q, k, v, window, dilation):
    B, S, H, Dh = q.shape
    L = window // dilation
    span = dilation * L
    Sp = -(-S // span) * span
    n = Sp // dilation
    nb = n // L

    def to_blocks(t):
        t = jnp.pad(t, ((0, 0), (0, Sp - S), (0, 0), (0, 0)))
        t = t.reshape(B, n, dilation, H, Dh).transpose(0, 2, 3, 1, 4)
        return t.reshape(B, dilation, H, nb, L, Dh)

    qb, kb, vb = to_blocks(q), to_blocks(k), to_blocks(v)

    def with_prev(t):
        prev = jnp.pad(t[:, :, :, :-1], ((0, 0), (0, 0), (0, 0), (1, 0), (0, 0), (0, 0)))
        return jnp.concatenate([prev, t], axis=4)

    k2, v2 = with_prev(kb), with_prev(vb)
    a = jnp.arange(L)[:, None]
    b = jnp.arange(2 * L)[None, :]
    band = (b >= a) & (b <= a + L)
    not_first = (jnp.arange(nb) > 0)[:, None, None]
    mask = band[None] & (not_first | (b >= L)[None])

    s = jnp.einsum('bdhnqe,bdhnke->bdhnqk', qb, k2) * (Dh ** -0.5)
    s = jnp.where(mask, s, NEG_INF)
    m = jnp.max(s, axis=-1, keepdims=True)
    p = jnp.exp(s - m)
    den = jnp.sum(p, axis=-1, keepdims=True)
    o = jnp.einsum('bdhnqk,bdhnke->bdhnqe', p, v2) / den
    lse = m + jnp.log(den)

    def from_blocks(t):
        last = t.shape[-1]
        t = t.reshape(B, dilation, H, n, last).transpose(0, 3, 1, 2, 4)
        return t.reshape(B, Sp, H, last)[:, :S]

    return from_blocks(o), from_blocks(lse)[..., 0]


def _mixer(h, w_in, sgu_norm_g, sgu_w, sgu_b, q_norm_g, k_norm_g, w_proj_a, w_proj_b, w_out):
    B, S, _ = h.shape
    proj = h @ w_in
    splits = np.cumsum([SGU_WIDTH, SGU_WIDTH, ATT_WIDTH, ATT_WIDTH, ATT_WIDTH, D_MODEL]).tolist()
    u, v_sgu, q, k, v_att, g_a, g_b = jnp.split(proj, splits, axis=-1)

    y_a = _spatial_gating(jax.nn.gelu(u), jax.nn.gelu(v_sgu), sgu_norm_g, sgu_w, sgu_b) @ w_proj_a

    q = _rmsnorm(q.reshape(B, S, ATT_HEADS, ATT_HEAD_DIM), q_norm_g).astype(jnp.float32)
    k = _rmsnorm(k.reshape(B, S, ATT_HEADS, ATT_HEAD_DIM), k_norm_g).astype(jnp.float32)
    v_att = v_att.reshape(B, S, ATT_HEADS, ATT_HEAD_DIM).astype(jnp.float32)
    outs, lses = [], []
    for window, dilation in DILATED_PATTERNS:
        o_p, lse_p = _dilated_window_attention(q, k, v_att, window, dilation)
        outs.append(o_p)
        lses.append(lse_p)
    alpha = jax.nn.softmax(jnp.stack(lses, axis=0), axis=0)
    o = jnp.einsum('pbsh,pbshe->bshe', alpha, jnp.stack(outs, axis=0))
    y_b = o.reshape(B, S, ATT_WIDTH).astype(h.dtype) @ w_proj_b

    merged = jax.nn.sigmoid(g_a) * y_a + jax.nn.sigmoid(g_b) * y_b
    return merged @ w_out


def _hierarchical_moe(h, w_rg, b_rg, w_re, b_re, w_gate, w_up, w_down):
    B, S, D = h.shape
    t = h.reshape(B * S, D)
    g_logits = (t @ w_rg + b_rg).astype(jnp.float32)
    g_prob = jax.nn.softmax(g_logits, axis=-1)
    g_top = jnp.argmax(g_logits, axis=-1)
    p_group = jnp.take_along_axis(g_prob, g_top[:, None], axis=-1)
    e_logits = (jnp.einsum('td,gde->tge', t, w_re) + b_re).astype(jnp.float32)
    e_logits = jnp.take_along_axis(e_logits, g_top[:, None, None], axis=1)[:, 0]
    top_val, top_idx = lax.top_k(e_logits, TOP_K_EXPERTS)
    p_exp = jax.nn.softmax(top_val, axis=-1) * p_group
    expert_ids = g_top[:, None] * EXPERTS_PER_GROUP + top_idx
    combine = jnp.sum(jax.nn.one_hot(expert_ids, N_EXPERTS, dtype=jnp.float32) * p_exp[..., None], axis=1)
    combine = combine.astype(t.dtype)
    y = jnp.zeros_like(t)
    for e in range(N_EXPERTS):
        he = jax.nn.silu(t @ w_gate[e]) * (t @ w_up[e])
        y = y + combine[:, e:e + 1] * (he @ w_down[e])
    return y.reshape(B, S, D)


def setup_inputs(seed: int = 0) -> dict:
    key = jax.random.key(seed)
    ks = jax.random.split(key, 24)
    f32 = jnp.float32

    def nrm(k, shape, scale):
        return jax.random.normal(k, shape, f32) * scale

    Dp = DEPTH
    return {
        "x": nrm(ks[0], (BATCH, SEQ, D_MODEL), 1.0),
        "c": nrm(ks[1], (BATCH, D_MODEL), 1.0),
        "w_ada": nrm(ks[2], (Dp, D_MODEL, 6 * D_MODEL), 0.5 * D_MODEL ** -0.5),
        "b_ada": nrm(ks[3], (Dp, 6 * D_MODEL), 0.02),
        "norm1_g": 1.0 + nrm(ks[4], (Dp, D_MODEL), 0.02),
        "w_in": nrm(ks[5], (Dp, D_MODEL, IN_WIDTH), D_MODEL ** -0.5),
        "sgu_norm_g": 1.0 + nrm(ks[6], (Dp, SGU_WIDTH), 0.02),
        "sgu_w": nrm(ks[7], (Dp, SGU_GROUPS, CHUNK, CHUNK), CHUNK ** -0.5),
        "sgu_b": 1.0 + nrm(ks[8], (Dp, SGU_GROUPS, CHUNK), 0.02),
        "q_norm_g": 1.0 + nrm(ks[9], (Dp, ATT_HEAD_DIM), 0.02),
        "k_norm_g": 1.0 + nrm(ks[10], (Dp, ATT_HEAD_DIM), 0.02),
        "w_proj_a": nrm(ks[11], (Dp, SGU_WIDTH, D_MODEL), SGU_WIDTH ** -0.5),
        "w_proj_b": nrm(ks[12], (Dp, ATT_WIDTH, D_MODEL), ATT_WIDTH ** -0.5),
        "w_out": nrm(ks[13], (Dp, D_MODEL, D_MODEL), D_MODEL ** -0.5),
        "norm2_g": 1.0 + nrm(ks[14], (Dp, D_MODEL), 0.02),
        "w_router_group": nrm(ks[15], (Dp, D_MODEL, N_GROUPS), D_MODEL ** -0.5),
        "b_router_group": nrm(ks[16], (Dp, N_GROUPS), 0.01),
        "w_router_expert": nrm(ks[17], (Dp, N_GROUPS, D_MODEL, EXPERTS_PER_GROUP), D_MODEL ** -0.5),
        "b_router_expert": nrm(ks[18], (Dp, N_GROUPS, EXPERTS_PER_GROUP), 0.01),
        "w_gate": nrm(ks[19], (Dp, N_EXPERTS, D_MODEL, D_EXPERT), D_MODEL ** -0.5),
        "w_up": nrm(ks[20], (Dp, N_EXPERTS, D_MODEL, D_EXPERT), D_MODEL ** -0.5),
        "w_down": nrm(ks[21], (Dp, N_EXPERTS, D_EXPERT, D_MODEL), D_EXPERT ** -0.5),
    }


def reference(x, c, w_ada, b_ada, norm1_g, w_in, sgu_norm_g, sgu_w, sgu_b, q_norm_g, k_norm_g,
              w_proj_a, w_proj_b, w_out, norm2_g, w_router_group, b_router_group,
              w_router_expert, b_router_expert, w_gate, w_up, w_down):
    cond = jax.nn.silu(c)
    for l in range(DEPTH):
        mod = cond @ w_ada[l] + b_ada[l]
        shift1, scale1, gate1, shift2, scale2, gate2 = jnp.split(mod, 6, axis=-1)
        h = _modulate(_rmsnorm(x, norm1_g[l]), shift1, scale1)
        y = _mixer(h, w_in[l], sgu_norm_g[l], sgu_w[l], sgu_b[l], q_norm_g[l], k_norm_g[l],
                   w_proj_a[l], w_proj_b[l], w_out[l])
        x = x + gate1[:, None, :] * y
        h2 = _modulate(_rmsnorm(x, norm2_g[l]), shift2, scale2)
        y2 = _hierarchical_moe(h2, w_router_group[l], b_router_group[l], w_router_expert[l],
                               b_router_expert[l], w_gate[l], w_up[l], w_down[l])
        x = x + gate2[:, None, :] * y2
    return x
```

```cpp
#include <hip/hip_runtime.h>
#include <cstdio>
#include <cstdint>

typedef unsigned short bf16;
typedef float f32x4 __attribute__((ext_vector_type(4)));
typedef unsigned u32x4 __attribute__((ext_vector_type(4)));
typedef unsigned u32x2 __attribute__((ext_vector_type(2)));

constexpr int NB = 16, S = 2048, D = 1024, T = NB * S, INW = 7168, NH = 8, DH = 128, NE = 16, DE = 512;
constexpr float EPS = 1e-6f;
constexpr float LOG2E = 1.4426950408889634f;
constexpr float QSCALE = 0.08838834764831845f * LOG2E;

constexpr size_t MiB = 1u << 20;
constexpr size_t WS_CTL = 0;
constexpr size_t WS_WIN = 2 * MiB;
constexpr size_t WS_WAB = 16 * MiB;
constexpr size_t WS_WO = 20 * MiB;
constexpr size_t WS_WGU = 22 * MiB;
constexpr size_t WS_WD = 54 * MiB;
constexpr size_t WS_MOD = 70 * MiB;
constexpr size_t WS_VSTAT = 71 * MiB;
constexpr size_t WS_RE = 72 * MiB;
constexpr size_t WS_RP = WS_RE + 256 * 1024;
constexpr size_t WS_RW = WS_RE + 512 * 1024;
constexpr size_t WS_TOK = 73 * MiB;
constexpr size_t WS_WSL = 75 * MiB;
constexpr size_t WS_SW = 77 * MiB;
constexpr size_t WS_GV = 80 * MiB;
constexpr size_t WS_Q = 144 * MiB;
constexpr size_t WS_K = 208 * MiB;
constexpr size_t WS_V = 272 * MiB;
constexpr size_t WS_SA = 336 * MiB;
constexpr size_t WS_SB = 400 * MiB;
constexpr size_t WS_YA = 464 * MiB;
constexpr size_t WS_END = 512 * MiB;
constexpr size_t WS_Y2 = 80 * MiB;
constexpr size_t WS_ACT = 336 * MiB;
constexpr size_t WS_MG = WS_K, WS_H2 = WS_V;
constexpr int CTL_CNT = 1024;
constexpr int MAXROWS = 2 * T + NE * 256;

__device__ __forceinline__ unsigned f2bf(float f) { unsigned u = __builtin_bit_cast(unsigned, f); return (u + 0x7fffu + ((u >> 16) & 1u)) >> 16; }
__device__ __forceinline__ unsigned pk2(float lo, float hi) { return f2bf(lo) | (f2bf(hi) << 16); }
__device__ __forceinline__ float bf2f(unsigned short b) { return __builtin_bit_cast(float, ((unsigned)b) << 16); }
__device__ __forceinline__ float bflo(unsigned w) { return __builtin_bit_cast(float, w << 16); }
__device__ __forceinline__ float bfhi(unsigned w) { return __builtin_bit_cast(float, w & 0xffff0000u); }
__device__ __forceinline__ float wave_sum(float v) {
#pragma unroll
    for (int o = 1; o < 64; o <<= 1) v += __shfl_xor(v, o);
    return v;
}
__device__ __forceinline__ float gelu_tanh(float x) {
    const float u = 0.7978845608028654f * (x + 0.044715f * x * x * x);
    return x / (1.0f + __expf(-2.0f * u));
}
__device__ __forceinline__ float sigmoidf_(float x) { return 1.0f / (1.0f + __expf(-x)); }

__device__ __forceinline__ void transpose_item(const float* W, int N, int k0, int n0, bf16* dst  , int ldd, float* scr, int lane) {
#pragma unroll 8
    for (int i = 0; i < 32; ++i) { const int kk = 2 * i + (lane >> 5); scr[kk * 33 + (lane & 31)] = W[(size_t)(k0 + kk) * N + n0 + (lane & 31)]; }
    asm volatile("s_waitcnt lgkmcnt(0)" ::: "memory");
    const int c = lane & 7;
#pragma unroll
    for (int j = 0; j < 4; ++j) { const int n = (lane >> 3) + 8 * j; const float* s = scr + (8 * c) * 33 + n;
        u32x4 o; o.x = pk2(s[0 * 33], s[1 * 33]); o.y = pk2(s[2 * 33], s[3 * 33]); o.z = pk2(s[4 * 33], s[5 * 33]); o.w = pk2(s[6 * 33], s[7 * 33]);
        *(u32x4*)(dst + (size_t)n * ldd + 8 * c) = o; }
    asm volatile("s_waitcnt lgkmcnt(0)" ::: "memory");
}

struct PrepArgs { const float *w_in, *wa, *wb, *wo, *wg, *wu, *wd, *sgu_w; unsigned char* ws; };
__global__ __launch_bounds__(256) void k_prep(PrepArgs a) {
    __shared__ float scr_all[4][64 * 33];
    const int wave = threadIdx.x >> 6, lane = threadIdx.x & 63;
    float* scr = scr_all[wave];
    const int gw = blockIdx.x * 4 + wave, NGW = gridDim.x * 4;
    constexpr int I_IN = (D / 64) * (INW / 32), I_SQ = (D / 64) * (D / 32), I_GU = (D / 64) * (DE / 32), I_D = (DE / 64) * (D / 32);
    constexpr int NIT = I_IN + 3 * I_SQ + NE * (2 * I_GU + I_D);
    bf16* WIN = (bf16*)(a.ws + WS_WIN); bf16* WAB = (bf16*)(a.ws + WS_WAB); bf16* WO = (bf16*)(a.ws + WS_WO); bf16* WGU = (bf16*)(a.ws + WS_WGU); bf16* WDn = (bf16*)(a.ws + WS_WD);
    for (int it = gw; it < NIT; it += NGW) {
        int r = it;
        if (r < I_IN) { const int nblk = INW / 32, kb = r / nblk, nb = r % nblk; transpose_item(a.w_in, INW, 64 * kb, 32 * nb, WIN + (size_t)(32 * nb) * D + 64 * kb, D, scr, lane); continue; } r -= I_IN;
        if (r < I_SQ) { const int nblk = D / 32, kb = r / nblk, nb = r % nblk; transpose_item(a.wa, D, 64 * kb, 32 * nb, WAB + (size_t)(32 * nb) * 2048 + 64 * kb, 2048, scr, lane); continue; } r -= I_SQ;
        if (r < I_SQ) { const int nblk = D / 32, kb = r / nblk, nb = r % nblk; transpose_item(a.wb, D, 64 * kb, 32 * nb, WAB + (size_t)(32 * nb) * 2048 + 1024 + 64 * kb, 2048, scr, lane); continue; } r -= I_SQ;
        if (r < I_SQ) { const int nblk = D / 32, kb = r / nblk, nb = r % nblk; transpose_item(a.wo, D, 64 * kb, 32 * nb, WO + (size_t)(32 * nb) * D + 64 * kb, D, scr, lane); continue; } r -= I_SQ;
        const int per_e = 2 * I_GU + I_D; const int e = r / per_e; r -= e * per_e;
        if (r < 2 * I_GU) { const int up = r / I_GU; r -= up * I_GU; const int nblk = DE / 32, kb = r / nblk, nb = r % nblk; const int n0 = 32 * nb;
            const int drow = 256 * (n0 >> 7) + 128 * up + (n0 & 127);
            transpose_item((up ? a.wu : a.wg) + (size_t)e * D * DE, DE, 64 * kb, n0, WGU + ((size_t)e * 1024 + drow) * D + 64 * kb, D, scr, lane); continue; }
        r -= 2 * I_GU;
        { const int nblk = D / 32, kb = r / nblk, nb = r % nblk; transpose_item(a.wd + (size_t)e * DE * D, D, 64 * kb, 32 * nb, WDn + ((size_t)e * 1024 + 32 * nb) * DE + 64 * kb, DE, scr, lane); }
    }
    bf16* SW = (bf16*)(a.ws + WS_SW);
    for (int i = blockIdx.x * 256 + threadIdx.x; i < 8 * 128 * 128; i += gridDim.x * 256) { const int s = i & 127, t = (i >> 7) & 127; SW[i] = (bf16)f2bf(s <= t ? a.sgu_w[i] : 0.f); }
}

__global__ __launch_bounds__(512) void k_mod(const float* c, const float* w_ada, const float* b_ada, float* mod) {
    extern __shared__ __attribute__((aligned(16))) unsigned char lds_raw[];
    float* sc = (float*)lds_raw;
    float* red = sc + 1024 * 16;
    const int tid = threadIdx.x, wave = tid >> 6, lane = tid & 63;
    for (int i = tid; i < 16 * 1024; i += 512) { const int b = i >> 10, k = i & 1023; const float v = c[i]; sc[k * 16 + b] = v / (1.0f + __expf(-v)); }
    __syncthreads();
    for (int item = blockIdx.x; item < 6144 / 64; item += gridDim.x) {
        const int n0 = item * 64;
        float acc[16];
#pragma unroll
        for (int b = 0; b < 16; ++b) acc[b] = 0.f;
        for (int k = wave * 128; k < wave * 128 + 128; ++k) {
            const float wv = w_ada[(size_t)k * 6144 + n0 + lane];
            const f32x4* sp = (const f32x4*)(sc + k * 16);
#pragma unroll
            for (int q = 0; q < 4; ++q) { const f32x4 s4 = sp[q]; acc[4 * q + 0] += s4.x * wv; acc[4 * q + 1] += s4.y * wv; acc[4 * q + 2] += s4.z * wv; acc[4 * q + 3] += s4.w * wv; }
        }
#pragma unroll
        for (int b = 0; b < 16; ++b) red[(wave * 16 + b) * 64 + lane] = acc[b];
        __syncthreads();
        for (int o = tid; o < 1024; o += 512) { const int b = o >> 6, l = o & 63; float s = b_ada[n0 + l];
#pragma unroll
            for (int w = 0; w < 8; ++w) s += red[(w * 16 + b) * 64 + l];
            mod[b * 6144 + n0 + l] = s; }
        __syncthreads();
    }
}

__global__ __launch_bounds__(256) void k_h(const float* x, const float* g1, const float* mod, bf16* Hh) {
    const int wave = threadIdx.x >> 6, lane = threadIdx.x & 63;
    const int gw = blockIdx.x * 4 + wave, NGW = gridDim.x * 4;
    for (int row = gw; row < T; row += NGW) {
        const int b = row >> 11;
        const f32x4* xr = (const f32x4*)(x + (size_t)row * D) + lane;
        f32x4 v[4]; float ss = 0.f;
#pragma unroll
        for (int j = 0; j < 4; ++j) { v[j] = xr[64 * j]; ss += (v[j].x * v[j].x + v[j].y * v[j].y) + (v[j].z * v[j].z + v[j].w * v[j].w); }
        const float rs = 1.0f / sqrtf(wave_sum(ss) * (1.0f / D) + EPS);
        const float* shift = mod + b * 6144; const float* scale = shift + 1024;
#pragma unroll
        for (int j = 0; j < 4; ++j) { const int col = (64 * j + lane) * 4;
            const f32x4 g = *(const f32x4*)(g1 + col), sc = *(const f32x4*)(scale + col), sh = *(const f32x4*)(shift + col);
            const f32x4 o = v[j] * rs * g * (1.0f + sc) + sh;
            u32x2 w; w.x = pk2(o.x, o.y); w.y = pk2(o.z, o.w);
            *(u32x2*)(Hh + (size_t)row * D + col) = w; }
    }
}

template <class P> __global__ __launch_bounds__(256) void k_gemm_naive(P p) {
    __shared__ __attribute__((aligned(16))) float As[32][68];
    __shared__ __attribute__((aligned(16))) float Bs[32][68];
    const int tm = blockIdx.y, tn = blockIdx.x;
    if (!p.valid(tm)) return;
    const int tx = threadIdx.x & 15, ty = threadIdx.x >> 4;
    const int lr = threadIdx.x >> 2, lk = (threadIdx.x & 3) * 8;
    const bf16* arow = p.a_row(tm * 64 + lr);
    const bf16* brow = p.b_row(tm, tn * 64 + lr);
    float acc[4][4];
#pragma unroll
    for (int i = 0; i < 4; ++i)
#pragma unroll
        for (int j = 0; j < 4; ++j) acc[i][j] = 0.f;
    for (int k0 = 0; k0 < p.K; k0 += 32) {
        const u32x4 av = *(const u32x4*)(arow + k0 + lk), bv = *(const u32x4*)(brow + k0 + lk);
        As[lk + 0][lr] = bflo(av.x); As[lk + 1][lr] = bfhi(av.x); As[lk + 2][lr] = bflo(av.y); As[lk + 3][lr] = bfhi(av.y);
        As[lk + 4][lr] = bflo(av.z); As[lk + 5][lr] = bfhi(av.z); As[lk + 6][lr] = bflo(av.w); As[lk + 7][lr] = bfhi(av.w);
        Bs[lk + 0][lr] = bflo(bv.x); Bs[lk + 1][lr] = bfhi(bv.x); Bs[lk + 2][lr] = bflo(bv.y); Bs[lk + 3][lr] = bfhi(bv.y);
        Bs[lk + 4][lr] = bflo(bv.z); Bs[lk + 5][lr] = bfhi(bv.z); Bs[lk + 6][lr] = bflo(bv.w); Bs[lk + 7][lr] = bfhi(bv.w);
        __syncthreads();
#pragma unroll 8
        for (int kk = 0; kk < 32; ++kk) {
            const f32x4 a4 = *(const f32x4*)&As[kk][ty * 4], b4 = *(const f32x4*)&Bs[kk][tx * 4];
            acc[0][0] += a4.x * b4.x; acc[0][1] += a4.x * b4.y; acc[0][2] += a4.x * b4.z; acc[0][3] += a4.x * b4.w;
            acc[1][0] += a4.y * b4.x; acc[1][1] += a4.y * b4.y; acc[1][2] += a4.y * b4.z; acc[1][3] += a4.y * b4.w;
            acc[2][0] += a4.z * b4.x; acc[2][1] += a4.z * b4.y; acc[2][2] += a4.z * b4.z; acc[2][3] += a4.z * b4.w;
            acc[3][0] += a4.w * b4.x; acc[3][1] += a4.w * b4.y; acc[3][2] += a4.w * b4.z; acc[3][3] += a4.w * b4.w;
        }
        __syncthreads();
    }
#pragma unroll
    for (int i = 0; i < 4; ++i) { const int m = tm * 64 + ty * 4 + i, n = tn * 64 + tx * 4;
        p.epi(tm, m, n, acc[i][0], acc[i][1], acc[i][2], acc[i][3]); }
}
__device__ __forceinline__ void st4bf(bf16* p, float a, float b, float c, float d) { u32x2 w; w.x = pk2(a, b); w.y = pk2(c, d); *(u32x2*)p = w; }

struct PInProj {
    const bf16* A; const bf16* Bt; int K;
    bf16 *GU, *GV, *Q, *Kb, *V, *SA, *SB;
    __device__ bool valid(int) const { return true; }
    __device__ const bf16* a_row(int m) const { return A + (size_t)m * D; }
    __device__ const bf16* b_row(int, int n) const { return Bt + (size_t)n * D; }
    __device__ void epi(int, int m, int n, float a, float b, float c, float d) const {
        const int seg = n >> 10, col = n & 1023; const size_t o = (size_t)m * D + col;
        switch (seg) {
            case 0: st4bf(GU + o, gelu_tanh(a), gelu_tanh(b), gelu_tanh(c), gelu_tanh(d)); break;
            case 1: st4bf(GV + o, gelu_tanh(a), gelu_tanh(b), gelu_tanh(c), gelu_tanh(d)); break;
            case 2: st4bf(Q + o, a, b, c, d); break;
            case 3: st4bf(Kb + o, a, b, c, d); break;
            case 4: st4bf(V + o, a, b, c, d); break;
            case 5: st4bf(SA + o, sigmoidf_(a), sigmoidf_(b), sigmoidf_(c), sigmoidf_(d)); break;
            default: st4bf(SB + o, sigmoidf_(a), sigmoidf_(b), sigmoidf_(c), sigmoidf_(d)); break;
        }
    }
};
__global__ __launch_bounds__(256) void k_qknorm(bf16* Q, bf16* Kb, const float* qg, const float* kg) {
    const int wave = threadIdx.x >> 6, lane = threadIdx.x & 63;
    const int gw = blockIdx.x * 4 + wave, NGW = gridDim.x * 4;
    for (int it = gw; it < 2 * T; it += NGW) {
        const int row = it >> 1, isk = it & 1; bf16* p = (isk ? Kb : Q) + (size_t)row * D + lane * 16; const float* g = (isk ? kg : qg) + (lane & 7) * 16;
        u32x4 w0 = *(u32x4*)p, w1 = *(u32x4*)(p + 8);
        float v[16] = {bflo(w0.x), bfhi(w0.x), bflo(w0.y), bfhi(w0.y), bflo(w0.z), bfhi(w0.z), bflo(w0.w), bfhi(w0.w), bflo(w1.x), bfhi(w1.x), bflo(w1.y), bfhi(w1.y), bflo(w1.z), bfhi(w1.z), bflo(w1.w), bfhi(w1.w)};
        float ss = 0.f;
#pragma unroll
        for (int i = 0; i < 16; ++i) ss += v[i] * v[i];
        ss += __shfl_xor(ss, 1); ss += __shfl_xor(ss, 2); ss += __shfl_xor(ss, 4);
        const float rs = (1.0f / sqrtf(ss * (1.0f / DH) + EPS)) * (isk ? 1.0f : QSCALE);
#pragma unroll
        for (int i = 0; i < 16; ++i) v[i] = v[i] * rs * g[i];
        w0.x = pk2(v[0], v[1]); w0.y = pk2(v[2], v[3]); w0.z = pk2(v[4], v[5]); w0.w = pk2(v[6], v[7]);
        w1.x = pk2(v[8], v[9]); w1.y = pk2(v[10], v[11]); w1.z = pk2(v[12], v[13]); w1.w = pk2(v[14], v[15]);
        *(u32x4*)p = w0; *(u32x4*)(p + 8) = w1;
    }
}
__global__ __launch_bounds__(256) void k_vstat(const bf16* GV, float* vstat) {
    const int wave = threadIdx.x >> 6, lane = threadIdx.x & 63;
    const int gw = blockIdx.x * 4 + wave, NGW = gridDim.x * 4;
    for (int row = gw; row < T; row += NGW) {
        const bf16* p = GV + (size_t)row * D + lane * 16;
        const u32x4 w0 = *(const u32x4*)p, w1 = *(const u32x4*)(p + 8);
        const unsigned ww[8] = {w0.x, w0.y, w0.z, w0.w, w1.x, w1.y, w1.z, w1.w};
        float ss = 0.f;
#pragma unroll
        for (int i = 0; i < 8; ++i) { const float a = bflo(ww[i]), b = bfhi(ww[i]); ss += a * a + b * b; }
        ss = wave_sum(ss);
        if (lane == 0) vstat[row] = 1.0f / sqrtf(ss * (1.0f / D) + EPS);
    }
}
__global__ __launch_bounds__(256) void k_sgu_naive(const bf16* GU, const bf16* GV, const float* vstat, const float* gn, const float* sgu_w, const float* sgu_b, bf16* SG) {
    const int t = blockIdx.x, c = t & 127, t0 = t - c, ch = threadIdx.x * 4, g = ch >> 7;
    const float* wrow = sgu_w + ((size_t)g * 128 + c) * 128;
    float a0 = 0.f, a1 = 0.f, a2 = 0.f, a3 = 0.f;
    for (int s = 0; s <= c; ++s) {
        const float w = wrow[s] * vstat[t0 + s];
        const u32x2 v = *(const u32x2*)(GV + (size_t)(t0 + s) * D + ch);
        a0 += w * bflo(v.x); a1 += w * bfhi(v.x); a2 += w * bflo(v.y); a3 += w * bfhi(v.y);
    }
    const f32x4 g4 = *(const f32x4*)(gn + ch); const float bs = sgu_b[g * 128 + c];
    const u32x2 u = *(const u32x2*)(GU + (size_t)t * D + ch);
    st4bf(SG + (size_t)t * D + ch, bflo(u.x) * (a0 * g4.x + bs), bfhi(u.x) * (a1 * g4.y + bs), bflo(u.y) * (a2 * g4.z + bs), bfhi(u.y) * (a3 * g4.w + bs));
}
__global__ __launch_bounds__(256) void k_attn_naive(bf16* Q, const bf16* Kb, const bf16* V, const float* qg, const float* kg) {
    __shared__ float qs[4][128];
    __shared__ float ps[4][448];
    const int w = threadIdx.x >> 6, lane = threadIdx.x & 63;
    const int item = blockIdx.x * 4 + w; const int t = item >> 3, h = item & 7, tt = t & 2047;
    float gq = fmaxf(fabsf(qg[lane]), fabsf(qg[lane + 64])), gk = fmaxf(fabsf(kg[lane]), fabsf(kg[lane + 64]));
#pragma unroll
    for (int o = 1; o < 64; o <<= 1) { gq = fmaxf(gq, __shfl_xor(gq, o)); gk = fmaxf(gk, __shfl_xor(gk, o)); }
    const float M2 = 11.313708498984761f * LOG2E * gq * gk;
    bf16* qp = Q + (size_t)t * D + h * DH;
    { const unsigned qq = *(const unsigned*)(qp + 2 * lane); qs[w][2 * lane] = bflo(qq); qs[w][2 * lane + 1] = bfhi(qq); }
    __syncthreads();
    float lsum = 0.f;
    for (int idx = lane; idx < 448; idx += 64) {
        float pv = 0.f;
        if (idx < 387) { const int p = idx / 129, j = idx - p * 129; const int dt = j << (2 * p);
            if (dt <= tt) { const bf16* kp = Kb + (size_t)(t - dt) * D + h * DH; float s = 0.f;
#pragma unroll 4
                for (int d8 = 0; d8 < 16; ++d8) { const u32x4 kv = *(const u32x4*)(kp + d8 * 8); const float* q8 = &qs[w][d8 * 8];
                    s += q8[0] * bflo(kv.x) + q8[1] * bfhi(kv.x) + q8[2] * bflo(kv.y) + q8[3] * bfhi(kv.y) + q8[4] * bflo(kv.z) + q8[5] * bfhi(kv.z) + q8[6] * bflo(kv.w) + q8[7] * bfhi(kv.w); }
                pv = exp2f(s - M2); } }
        ps[w][idx] = pv; lsum += pv;
    }
    lsum = wave_sum(lsum);
    __syncthreads();
    float o0 = 0.f, o1 = 0.f;
    for (int idx = 0; idx < 387; ++idx) { const float pv = ps[w][idx];
        if (pv != 0.f) { const int p = idx / 129, j = idx - p * 129; const int dt = j << (2 * p);
            const unsigned vv = *(const unsigned*)(V + (size_t)(t - dt) * D + h * DH + 2 * lane); o0 += pv * bflo(vv); o1 += pv * bfhi(vv); } }
    const float inv = 1.0f / lsum;
    *(unsigned*)(qp + 2 * lane) = pk2(o0 * inv, o1 * inv);
}
struct PProjA { const bf16* A; const bf16* Bt; int K; const bf16* SA; bf16* YA;
    __device__ bool valid(int) const { return true; }
    __device__ const bf16* a_row(int m) const { return A + (size_t)m * D; }
    __device__ const bf16* b_row(int, int n) const { return Bt + (size_t)n * 2048; }
    __device__ void epi(int, int m, int n, float a, float b, float c, float d) const { const size_t o = (size_t)m * D + n; const u32x2 s = *(const u32x2*)(SA + o);
        st4bf(YA + o, a * bflo(s.x), b * bfhi(s.x), c * bflo(s.y), d * bfhi(s.y)); } };
struct PProjB { const bf16* A; const bf16* Bt; int K; const bf16* SB; const bf16* YA; bf16* MG;
    __device__ bool valid(int) const { return true; }
    __device__ const bf16* a_row(int m) const { return A + (size_t)m * D; }
    __device__ const bf16* b_row(int, int n) const { return Bt + (size_t)n * 2048 + 1024; }
    __device__ void epi(int, int m, int n, float a, float b, float c, float d) const { const size_t o = (size_t)m * D + n; const u32x2 s = *(const u32x2*)(SB + o), y = *(const u32x2*)(YA + o);
        st4bf(MG + o, bflo(y.x) + a * bflo(s.x), bfhi(y.x) + b * bfhi(s.x), bflo(y.y) + c * bflo(s.y), bfhi(y.y) + d * bfhi(s.y)); } };
struct POut { const bf16* A; const bf16* Bt; int K; const float* x; const float* mod; float* x1;
    __device__ bool valid(int) const { return true; }
    __device__ const bf16* a_row(int m) const { return A + (size_t)m * D; }
    __device__ const bf16* b_row(int, int n) const { return Bt + (size_t)n * D; }
    __device__ void epi(int, int m, int n, float a, float b, float c, float d) const { const size_t o = (size_t)m * D + n; const f32x4 xv = *(const f32x4*)(x + o);
        const f32x4 g = *(const f32x4*)(mod + (m >> 11) * 6144 + 2048 + n); f32x4 r; r.x = xv.x + g.x * a; r.y = xv.y + g.y * b; r.z = xv.z + g.z * c; r.w = xv.w + g.w * d; *(f32x4*)(x1 + o) = r; } };

__global__ __launch_bounds__(512) void k_route(const float* x1, const float* g2, const float* mod, const float* w_rg, const float* b_rg, const float* w_re, const float* b_re,
                                               bf16* H2, int* RE, int* RP, float* RW, int* TOK, float* WSL, unsigned* cnt) {
    extern __shared__ __attribute__((aligned(16))) unsigned char lds_raw[];
    float* Wr = (float*)lds_raw;
    int* lcnt = (int*)(Wr + 20 * 1024);
    int* gbase = lcnt + 16;
    int* dec_e = gbase + 16;
    int* dec_lp = dec_e + 256;
    float* dec_w = (float*)(dec_lp + 256);
    float* lgs = dec_w + 256;
    const int tid = threadIdx.x, wave = tid >> 6, lane = tid & 63;
    for (int i = tid; i < 20 * 1024; i += 512) { const int j = i >> 10, k = i & 1023; Wr[i] = (j < 4) ? w_rg[k * 4 + j] : w_re[(size_t)((j - 4) >> 2) * 4096 + k * 4 + ((j - 4) & 3)]; }
    for (int blk = blockIdx.x; blk < T / 128; blk += gridDim.x) {
        if (tid < 16) lcnt[tid] = 0;
        __syncthreads();
        const int b = (blk * 128) >> 11;
        const float* shift = mod + b * 6144 + 3072; const float* scale = shift + 1024;
        for (int rr = 0; rr < 16; ++rr) {
            const int lrow = wave * 16 + rr, row = blk * 128 + lrow;
            const f32x4* xr = (const f32x4*)(x1 + (size_t)row * D) + lane;
            f32x4 v[4]; float ss = 0.f;
#pragma unroll
            for (int j = 0; j < 4; ++j) { v[j] = xr[64 * j]; ss += (v[j].x * v[j].x + v[j].y * v[j].y) + (v[j].z * v[j].z + v[j].w * v[j].w); }
            const float rs = 1.0f / sqrtf(wave_sum(ss) * (1.0f / D) + EPS);
            f32x4 o[4];
#pragma unroll
            for (int j = 0; j < 4; ++j) { const int col = (64 * j + lane) * 4;
                const f32x4 g = *(const f32x4*)(g2 + col), sc = *(const f32x4*)(scale + col), sh = *(const f32x4*)(shift + col);
                o[j] = v[j] * rs * g * (1.0f + sc) + sh;
                u32x2 w; w.x = pk2(o[j].x, o[j].y); w.y = pk2(o[j].z, o[j].w);
                *(u32x2*)(H2 + (size_t)row * D + col) = w; }
#pragma unroll 2
            for (int q = 0; q < 20; ++q) { float s = 0.f;
#pragma unroll
                for (int j = 0; j < 4; ++j) { const f32x4 wr = *(const f32x4*)(Wr + q * 1024 + (64 * j + lane) * 4); s += (o[j].x * wr.x + o[j].y * wr.y) + (o[j].z * wr.z + o[j].w * wr.w); }
                s = wave_sum(s);
                if (lane == 0) lgs[wave * 32 + q] = s; }
            asm volatile("s_waitcnt lgkmcnt(0)" ::: "memory");
            const float* lg = lgs + wave * 32;
            float gl[4];
#pragma unroll
            for (int j = 0; j < 4; ++j) gl[j] = lg[j] + b_rg[j];
            int gt = 0; float gm = gl[0];
#pragma unroll
            for (int j = 1; j < 4; ++j) if (gl[j] > gm) { gm = gl[j]; gt = j; }
            float den = 0.f;
#pragma unroll
            for (int j = 0; j < 4; ++j) den += __expf(gl[j] - gm);
            const float pgroup = 1.0f / den;
            float el[4];
#pragma unroll
            for (int e = 0; e < 4; ++e) el[e] = lg[4 + gt * 4 + e] + b_re[gt * 4 + e];
            int i0 = 0; float v0 = el[0];
#pragma unroll
            for (int e = 1; e < 4; ++e) if (el[e] > v0) { v0 = el[e]; i0 = e; }
            int i1 = -1; float v1 = -3.0e38f;
#pragma unroll
            for (int e = 0; e < 4; ++e) if (e != i0 && el[e] > v1) { v1 = el[e]; i1 = e; }
            const float e1 = __expf(v1 - v0); const float p0 = pgroup / (1.0f + e1), p1 = pgroup * e1 / (1.0f + e1);
            if (lane == 0) { const int ex0 = gt * 4 + i0, ex1 = gt * 4 + i1;
                dec_e[lrow * 2] = ex0; dec_e[lrow * 2 + 1] = ex1; dec_w[lrow * 2] = p0; dec_w[lrow * 2 + 1] = p1;
                dec_lp[lrow * 2] = atomicAdd(&lcnt[ex0], 1); dec_lp[lrow * 2 + 1] = atomicAdd(&lcnt[ex1], 1); }
        }
        __syncthreads();
        if (tid < 16) gbase[tid] = (int)atomicAdd(&cnt[tid], (unsigned)lcnt[tid]);
        __syncthreads();
        if (tid < 256) { const int e = dec_e[tid], pos = gbase[e] + dec_lp[tid]; const int tok = blk * 128 + (tid >> 1); const float w = dec_w[tid];
            RE[tok * 2 + (tid & 1)] = e; RP[tok * 2 + (tid & 1)] = pos; RW[tok * 2 + (tid & 1)] = w; TOK[(size_t)e * T + pos] = tok; WSL[(size_t)e * T + pos] = w; }
        __syncthreads();
    }
}
struct ExpMap { const unsigned* cnt;
    __device__ bool find(int row0  , int& e, int& lrow, int& n) const {
        int base = 0;
        for (int i = 0; i < NE; ++i) { const int c = (int)cnt[i]; const int pad = (c + 255) & ~255; if (row0 < base + pad) { e = i; lrow = row0 - base; n = c; return true; } base += pad; }
        return false; } };
struct PMoe1 { const bf16* H2; const bf16* WGU; int K; ExpMap em; const int* TOK; bf16* ACT;
    __device__ bool valid(int tm) const { int e, l, n; return em.find(tm * 64, e, l, n); }
    __device__ const bf16* a_row(int m) const { int e, l, n; em.find(m & ~63, e, l, n); l += (m & 63); const int tok = (l < n) ? TOK[(size_t)e * T + l] : 0; return H2 + (size_t)tok * D; }
    __device__ const bf16* b_row(int tm, int nn) const { int e, l, n; em.find(tm * 64, e, l, n); return WGU + ((size_t)e * 1024 + nn) * D; }
    bf16* RAW;
    __device__ void epi(int, int m, int nn, float a, float b, float c, float d) const { st4bf(RAW + (size_t)m * 1024 + nn, a, b, c, d); } };
__global__ __launch_bounds__(256) void k_swiglu(const bf16* RAW, bf16* ACT, const unsigned* cnt) {
    int tot = 0; for (int i = 0; i < NE; ++i) tot += ((int)cnt[i] + 255) & ~255;
    for (size_t i = (size_t)blockIdx.x * 256 + threadIdx.x; i < (size_t)tot * 512; i += (size_t)gridDim.x * 256) { const size_t m = i >> 9; const int j = (int)(i & 511);
        const int nn = 256 * (j >> 7) + (j & 127); const float g = bf2f(RAW[m * 1024 + nn]), u = bf2f(RAW[m * 1024 + nn + 128]);
        ACT[m * 512 + j] = (bf16)f2bf(g / (1.0f + __expf(-g)) * u); }
}
struct PMoe2 { const bf16* ACT; const bf16* WDn; int K; ExpMap em; const float* WSL; bf16* Y2;
    __device__ bool valid(int tm) const { int e, l, n; return em.find(tm * 64, e, l, n); }
    __device__ const bf16* a_row(int m) const { return ACT + (size_t)m * DE; }
    __device__ const bf16* b_row(int tm, int nn) const { int e, l, n; em.find(tm * 64, e, l, n); return WDn + ((size_t)e * 1024 + nn) * DE; }
    __device__ void epi(int tm, int m, int nn, float a, float b, float c, float d) const { int e, l, n; em.find(tm * 64, e, l, n); l += (m & 63); const float w = (l < n) ? WSL[(size_t)e * T + l] : 0.f;
        st4bf(Y2 + (size_t)m * D + nn, a * w, b * w, c * w, d * w); } };
__global__ __launch_bounds__(256) void k_final(float* out, const float* mod, const bf16* Y2, const int* RE, const int* RP, const unsigned* cnt) {
    const int wave = threadIdx.x >> 6, lane = threadIdx.x & 63;
    const int gw = blockIdx.x * 4 + wave, NGW = gridDim.x * 4;
    int rb[NE]; { int base = 0;
#pragma unroll
        for (int i = 0; i < NE; ++i) { rb[i] = base; base += ((int)cnt[i] + 255) & ~255; } }
    for (int row = gw; row < T; row += NGW) {
        const int e0 = RE[row * 2], e1 = RE[row * 2 + 1]; int b0 = 0, b1 = 0;
#pragma unroll
        for (int i = 0; i < NE; ++i) { b0 = (e0 == i) ? rb[i] : b0; b1 = (e1 == i) ? rb[i] : b1; }
        const size_t s0 = (size_t)(b0 + RP[row * 2]), s1 = (size_t)(b1 + RP[row * 2 + 1]);
        const float* gate = mod + (row >> 11) * 6144 + 5120;
#pragma unroll
        for (int j = 0; j < 4; ++j) { const int col = (64 * j + lane) * 4; float* op = out + (size_t)row * D + col;
            const f32x4 xv = *(const f32x4*)op, g = *(const f32x4*)(gate + col);
            const u32x2 y0 = *(const u32x2*)(Y2 + s0 * D + col), y1 = *(const u32x2*)(Y2 + s1 * D + col);
            f32x4 r; r.x = xv.x + g.x * (bflo(y0.x) + bflo(y1.x)); r.y = xv.y + g.y * (bfhi(y0.x) + bfhi(y1.x)); r.z = xv.z + g.z * (bflo(y0.y) + bflo(y1.y)); r.w = xv.w + g.w * (bfhi(y0.y) + bfhi(y1.y));
            *(f32x4*)op = r; }
    }
}

extern "C" void kernel_launch(void* const* d_in, const int* in_sizes, int n_in, void* d_out, int out_size, void* d_ws, size_t ws_size, hipStream_t stream) {
    static int ok = 0;
    if (ok == 0) {
        if (n_in != 22 || in_sizes[0] != T * D || out_size != T * D || ws_size < WS_END) { fprintf(stderr, "kernel_launch: shape/ws mismatch n_in %d in0 %d out %d ws %zu\n", n_in, n_in > 0 ? in_sizes[0] : -1, out_size, ws_size); ok = -1; return; }
        hipFuncSetAttribute((const void*)k_mod, hipFuncAttributeMaxDynamicSharedMemorySize, 98304);
        hipFuncSetAttribute((const void*)k_route, hipFuncAttributeMaxDynamicSharedMemorySize, 90112);
        ok = 1;
    }
    if (ok < 0) return;
    const float* x = (const float*)d_in[0]; const float* c = (const float*)d_in[1]; const float* w_ada = (const float*)d_in[2]; const float* b_ada = (const float*)d_in[3];
    const float* g1 = (const float*)d_in[4]; const float* w_in = (const float*)d_in[5]; const float* sgn = (const float*)d_in[6]; const float* sgu_w = (const float*)d_in[7];
    const float* sgu_b = (const float*)d_in[8]; const float* qg = (const float*)d_in[9]; const float* kg = (const float*)d_in[10]; const float* wa = (const float*)d_in[11];
    const float* wb = (const float*)d_in[12]; const float* wo = (const float*)d_in[13]; const float* g2 = (const float*)d_in[14]; const float* w_rg = (const float*)d_in[15];
    const float* b_rg = (const float*)d_in[16]; const float* w_re = (const float*)d_in[17]; const float* b_re = (const float*)d_in[18]; const float* wg = (const float*)d_in[19];
    const float* wu = (const float*)d_in[20]; const float* wd = (const float*)d_in[21];
    unsigned char* ws = (unsigned char*)d_ws; float* out = (float*)d_out;
    hipMemsetAsync(ws + WS_CTL, 0, 1 * MiB, stream);
    bf16* Hh = (bf16*)d_out; bf16* GU = (bf16*)((unsigned char*)d_out + 64 * MiB); bf16* SG = Hh;
    bf16* GV = (bf16*)(ws + WS_GV); bf16* Q = (bf16*)(ws + WS_Q); bf16* Kb = (bf16*)(ws + WS_K); bf16* V = (bf16*)(ws + WS_V); bf16* SA = (bf16*)(ws + WS_SA); bf16* SB = (bf16*)(ws + WS_SB);
    bf16* YA = GV; bf16* MG = (bf16*)(ws + WS_MG); bf16* H2 = (bf16*)(ws + WS_H2); bf16* ACT = (bf16*)(ws + WS_ACT); bf16* Y2 = (bf16*)(ws + WS_Y2);
    bf16* RAW = (bf16*)(ws + WS_Y2);
    float* mod = (float*)(ws + WS_MOD); float* vstat = (float*)(ws + WS_VSTAT); unsigned* cnt = (unsigned*)(ws + WS_CTL) + CTL_CNT;
    int* RE = (int*)(ws + WS_RE); int* RP = (int*)(ws + WS_RP); float* RW = (float*)(ws + WS_RW); int* TOK = (int*)(ws + WS_TOK); float* WSL = (float*)(ws + WS_WSL);

    PrepArgs pa{w_in, wa, wb, wo, wg, wu, wd, sgu_w, ws};
    hipLaunchKernelGGL(k_prep, dim3(2048), dim3(256), 0, stream, pa);
    hipLaunchKernelGGL(k_mod, dim3(96), dim3(512), 98304, stream, c, w_ada, b_ada, mod);
    hipLaunchKernelGGL(k_h, dim3(2048), dim3(256), 0, stream, x, g1, (const float*)mod, Hh);
    { PInProj p{Hh, (const bf16*)(ws + WS_WIN), D, GU, GV, Q, Kb, V, SA, SB}; hipLaunchKernelGGL(k_gemm_naive<PInProj>, dim3(INW / 64, T / 64), dim3(256), 0, stream, p); }
    hipLaunchKernelGGL(k_qknorm, dim3(2048), dim3(256), 0, stream, Q, Kb, qg, kg);
    hipLaunchKernelGGL(k_vstat, dim3(2048), dim3(256), 0, stream, (const bf16*)GV, vstat);
    hipLaunchKernelGGL(k_sgu_naive, dim3(T), dim3(256), 0, stream, (const bf16*)GU, (const bf16*)GV, (const float*)vstat, sgn, sgu_w, sgu_b, SG);
    hipLaunchKernelGGL(k_attn_naive, dim3(T * NH / 4), dim3(256), 0, stream, Q, (const bf16*)Kb, (const bf16*)V, qg, kg);
    { PProjA p{SG, (const bf16*)(ws + WS_WAB), D, SA, YA}; hipLaunchKernelGGL(k_gemm_naive<PProjA>, dim3(D / 64, T / 64), dim3(256), 0, stream, p); }
    { PProjB p{Q, (const bf16*)(ws + WS_WAB), D, SB, YA, MG}; hipLaunchKernelGGL(k_gemm_naive<PProjB>, dim3(D / 64, T / 64), dim3(256), 0, stream, p); }
    { POut p{MG, (const bf16*)(ws + WS_WO), D, x, mod, out}; hipLaunchKernelGGL(k_gemm_naive<POut>, dim3(D / 64, T / 64), dim3(256), 0, stream, p); }
    hipLaunchKernelGGL(k_route, dim3(256), dim3(512), 90112, stream, (const float*)out, g2, (const float*)mod, w_rg, b_rg, w_re, b_re, H2, RE, RP, RW, TOK, WSL, cnt);
    { PMoe1 p{H2, (const bf16*)(ws + WS_WGU), D, ExpMap{cnt}, TOK, ACT, RAW}; hipLaunchKernelGGL(k_gemm_naive<PMoe1>, dim3(1024 / 64, MAXROWS / 64), dim3(256), 0, stream, p); }
    hipLaunchKernelGGL(k_swiglu, dim3(4096), dim3(256), 0, stream, (const bf16*)RAW, ACT, (const unsigned*)cnt);
    { PMoe2 p{ACT, (const bf16*)(ws + WS_WD), DE, ExpMap{cnt}, WSL, Y2}; hipLaunchKernelGGL(k_gemm_naive<PMoe2>, dim3(D / 64, MAXROWS / 64), dim3(256), 0, stream, p); }
    hipLaunchKernelGGL(k_final, dim3(2048), dim3(256), 0, stream, out, (const float*)mod, (const bf16*)Y2, (const int*)RE, (const int*)RP, (const unsigned*)cnt);
}
```

```cpp
#include <hip/hip_runtime.h>
#include <cstdio>
#include <cstdint>

#define LAS __attribute__((address_space(3)))
typedef unsigned short bf16;
typedef float f32x4 __attribute__((ext_vector_type(4)));
typedef unsigned u32x4 __attribute__((ext_vector_type(4)));
typedef unsigned u32x2 __attribute__((ext_vector_type(2)));
typedef short bf16x8 __attribute__((ext_vector_type(8)));

constexpr int NB = 16, S = 2048, D = 1024, T = NB * S, INW = 7168, NH = 8, DH = 128, NE = 16, DE = 512, NCLS = 24;
constexpr float EPS = 1e-6f;
constexpr float LOG2E = 1.4426950408889634f;
constexpr float QSCALE = 0.08838834764831845f * LOG2E;

constexpr size_t MiB = 1u << 20;
constexpr size_t WS_CTL = 0;
constexpr size_t WS_WIN = 2 * MiB;
constexpr size_t WS_WAB = 16 * MiB;
constexpr size_t WS_WO = 20 * MiB;
constexpr size_t WS_WGU = 22 * MiB;
constexpr size_t WS_WD = 54 * MiB;
constexpr size_t WS_MOD = 70 * MiB;
constexpr size_t WS_VSTAT = 71 * MiB;
constexpr size_t WS_SW = 71 * MiB + 512 * 1024;
constexpr size_t WS_TOK = 72 * MiB;
constexpr size_t WS_WW = 464 * MiB;
constexpr size_t WS_GV = 80 * MiB;
constexpr size_t WS_Q = 144 * MiB;
constexpr size_t WS_K = 208 * MiB;
constexpr size_t WS_V = 272 * MiB;
constexpr size_t WS_SA = 336 * MiB;
constexpr size_t WS_SB = 400 * MiB;
constexpr size_t WS_END = 512 * MiB;
constexpr size_t WS_ACT = 336 * MiB;
constexpr size_t WS_MG = WS_K, WS_H2 = WS_Q;
constexpr size_t WS_X1 = WS_GV;
constexpr int CTL_CNT = 1024;
constexpr int CW_BAR = 4096;
constexpr int CW_PAN_MG = 32768, CW_PAN_X1 = 49152;
constexpr int CW_MOD = 2048;
constexpr int CW_TILE = 16384;

constexpr int LDS_STAGE = 0;
constexpr int LDS_EPI = 131072;
constexpr int LDS_MISC = 139264;
constexpr int LDS_BYTES = 147456;

__device__ __forceinline__ unsigned f2bf(float f) { unsigned u = __builtin_bit_cast(unsigned, f); return (u + 0x7fffu + ((u >> 16) & 1u)) >> 16; }
__device__ __forceinline__ unsigned pk2(float lo, float hi) { return f2bf(lo) | (f2bf(hi) << 16); }
__device__ __forceinline__ float bf2f(unsigned short b) { return __builtin_bit_cast(float, ((unsigned)b) << 16); }
__device__ __forceinline__ float bflo(unsigned w) { return __builtin_bit_cast(float, w << 16); }
__device__ __forceinline__ float bfhi(unsigned w) { return __builtin_bit_cast(float, w & 0xffff0000u); }
__device__ __forceinline__ unsigned cvt_pk_bf16(float lo, float hi) { unsigned r; asm volatile("v_cvt_pk_bf16_f32 %0, %1, %2" : "=v"(r) : "v"(lo), "v"(hi)); return r; }
__device__ __forceinline__ float wave_sum(float v) {
#pragma unroll
    for (int o = 1; o < 64; o <<= 1) v += __shfl_xor(v, o);
    return v;
}
__device__ __forceinline__ float row16_sum(float x) {
    x += __builtin_bit_cast(float, __builtin_amdgcn_update_dpp(0, __builtin_bit_cast(int, x), 0xB1, 0xF, 0xF, true));
    x += __builtin_bit_cast(float, __builtin_amdgcn_update_dpp(0, __builtin_bit_cast(int, x), 0x4E, 0xF, 0xF, true));
    x += __builtin_bit_cast(float, __builtin_amdgcn_update_dpp(0, __builtin_bit_cast(int, x), 0x141, 0xF, 0xF, true));
    x += __builtin_bit_cast(float, __builtin_amdgcn_update_dpp(0, __builtin_bit_cast(int, x), 0x140, 0xF, 0xF, true));
    return x;
}
__device__ __forceinline__ float rows_sum(float x) {
    { unsigned a = __builtin_bit_cast(unsigned, x), b = a; asm volatile("" : "+v"(b));
      const auto r = __builtin_amdgcn_permlane16_swap(a, b, false, false); x = __builtin_bit_cast(float, (unsigned)r[0]) + __builtin_bit_cast(float, (unsigned)r[1]); }
    { unsigned a = __builtin_bit_cast(unsigned, x), b = a; asm volatile("" : "+v"(b));
      const auto r = __builtin_amdgcn_permlane32_swap(a, b, false, false); x = __builtin_bit_cast(float, (unsigned)r[0]) + __builtin_bit_cast(float, (unsigned)r[1]); }
    return x;
}
__device__ __forceinline__ float wave_sum_dpp(float x) {
    x = row16_sum(x);
    { unsigned a = __builtin_bit_cast(unsigned, x), b = a; asm volatile("" : "+v"(b));
      const auto r = __builtin_amdgcn_permlane16_swap(a, b, false, false); x = __builtin_bit_cast(float, (unsigned)r[0]) + __builtin_bit_cast(float, (unsigned)r[1]); }
    { unsigned a = __builtin_bit_cast(unsigned, x), b = a; asm volatile("" : "+v"(b));
      const auto r = __builtin_amdgcn_permlane32_swap(a, b, false, false); x = __builtin_bit_cast(float, (unsigned)r[0]) + __builtin_bit_cast(float, (unsigned)r[1]); }
    return x;
}
__device__ __forceinline__ void st16_wt(void* base, unsigned byte_off, u32x4 v) {
    const __amdgpu_buffer_rsrc_t r = __builtin_amdgcn_make_buffer_rsrc(base, 0, 0x7fffffff, 0x00020000);
    __builtin_amdgcn_raw_buffer_store_b128(v, r, (int)byte_off, 0, 16);
}
__device__ __forceinline__ int lane_id_fresh() { int l; asm volatile("v_mbcnt_lo_u32_b32 %0, -1, 0\n\tv_mbcnt_hi_u32_b32 %0, -1, %0" : "=v"(l)); return l; }
__device__ __forceinline__ float fast_rcp(float x) { return __builtin_amdgcn_rcpf(x); }
__device__ __forceinline__ float gelu_tanh(float x) {
    const float u = x * (0.7978845608028654f + 0.035677408136300125f * x * x);
    return x * fast_rcp(1.0f + __builtin_amdgcn_exp2f(-2.0f * LOG2E * u));
}
__device__ __forceinline__ float sigmoidf_(float x) { return fast_rcp(1.0f + __builtin_amdgcn_exp2f(-LOG2E * x)); }
__device__ __forceinline__ f32x4 exp2_4(f32x4 t) { f32x4 e; e.x = __builtin_amdgcn_exp2f(t.x); e.y = __builtin_amdgcn_exp2f(t.y); e.z = __builtin_amdgcn_exp2f(t.z); e.w = __builtin_amdgcn_exp2f(t.w); return e; }
__device__ __forceinline__ f32x4 rcp_4(f32x4 t) { f32x4 e; e.x = fast_rcp(t.x); e.y = fast_rcp(t.y); e.z = fast_rcp(t.z); e.w = fast_rcp(t.w); return e; }
__device__ __forceinline__ f32x4 gelu4(f32x4 x) {
    const f32x4 t = x * (x * x * (-2.0f * LOG2E * 0.035677408136300125f) + (-2.0f * LOG2E * 0.7978845608028654f));
    return x * rcp_4(exp2_4(t) + 1.0f);
}
__device__ __forceinline__ f32x4 sigmoid4(f32x4 x) { return rcp_4(exp2_4(x * (-LOG2E)) + 1.0f); }
__device__ __forceinline__ float siluf_(float x) { return x * fast_rcp(1.0f + __builtin_amdgcn_exp2f(-LOG2E * x)); }

__device__ __forceinline__ unsigned dpp_swap1(unsigned x) { return (unsigned)__builtin_amdgcn_update_dpp(0, (int)x, 0xB1, 0xF, 0xF, false); }
template <bool NT> __device__ __forceinline__ void st_lines(char* p, unsigned ld, u32x4 w0, u32x4 w1, bool odd) {
    const u32x4 x = odd ? w0 : w1; u32x4 y; y.x = dpp_swap1(x.x); y.y = dpp_swap1(x.y); y.z = dpp_swap1(x.z); y.w = dpp_swap1(x.w);
    const u32x4 d1 = odd ? y : w0, d2 = odd ? w1 : y;
    if constexpr (NT) { __builtin_nontemporal_store(d1, (u32x4*)p); __builtin_nontemporal_store(d2, (u32x4*)(p + ld)); }
    else { *(u32x4*)p = d1; *(u32x4*)(p + ld) = d2; }
}
__device__ __forceinline__ void st_lines_wt(void* base, unsigned off, unsigned ld, u32x4 w0, u32x4 w1, bool odd) {
    const u32x4 x = odd ? w0 : w1; u32x4 y; y.x = dpp_swap1(x.x); y.y = dpp_swap1(x.y); y.z = dpp_swap1(x.z); y.w = dpp_swap1(x.w);
    st16_wt(base, off, odd ? y : w0); st16_wt(base, off + ld, odd ? w1 : y);
}
__device__ __forceinline__ void ld_lines_fix(u32x4 l1, u32x4 l2, bool odd, u32x4& w0, u32x4& w1) {
    const u32x4 x = odd ? l1 : l2; u32x4 y; y.x = dpp_swap1(x.x); y.y = dpp_swap1(x.y); y.z = dpp_swap1(x.z); y.w = dpp_swap1(x.w);
    w0 = odd ? y : l1; w1 = odd ? l2 : y;
}
namespace pg8 {
constexpr int BM = 256, BK = 64, HALF = 128, HTB = HALF * BK * 2, STAGE_BYTES = 8 * HTB, NXCD = 8, WGM = 4;
__host__ __device__ __forceinline__ int lds_byte(int r, int c) { const int st = (r >> 4) * 2 + (c >> 5), rr = r & 15, cc = c & 31, ob = rr * 64 + cc * 2; return st * 1024 + (ob ^ (((ob >> 9) & 1) << 5)); }
__host__ __device__ __forceinline__ void stage_rc(int b, int& R, int& C) { const int st = b / 1024, sb = b % 1024, swz = sb ^ (((sb >> 9) & 1) << 5); R = (st >> 1) * 16 + swz / 64; C = (st & 1) * 32 + (swz % 64) / 2; }
__host__ __device__ __forceinline__ int perm32(int rho) { const int n = rho >> 4, i = rho & 15; return 8 * (i >> 2) + 4 * n + (i & 3); }

struct Unit { const char* a; const char* a2; const char* b; const char* b2; const int* ridx; int nrows; int pm, pn, e, lt; };

template <class Epi, class Sched, bool GATHER, bool MIDK, bool BSPLIT = false>
__device__ __forceinline__ void gemm_phase(LAS unsigned char* lds, const int nt, const int ksplit, const int lda, const int ldb, const Sched& S, const Epi& E, const int TID) {
    const int tid = TID, wid = __builtin_amdgcn_readfirstlane(tid >> 6), lane = tid & 63, wr = wid >> 2, wc = wid & 3, fr = lane & 15, fq = lane >> 4;
    int RA[2], CA[2]; unsigned voffB[2];
#pragma unroll
    for (int i = 0; i < 2; ++i) { int R, C; stage_rc(tid * 16 + i * 8192, R, C); RA[i] = R; CA[i] = C; const int Rb = Epi::PERM == 2 ? (64 * (R >> 5) + perm32(R & 31)) : Epi::PERM == 1 ? ((R & ~31) + perm32(R & 31)) : R; voffB[i] = (unsigned)(Rb * ldb + C) * 2u; }
    unsigned cG[2][2], nG[2][2];
    const size_t kstep = (size_t)(BK * 2);
    const size_t hstepB = (size_t)(Epi::PERM == 2 ? 32 : HALF) * ldb * 2;
    const unsigned ldsw = (unsigned)wid * 1024u;
    const int aoff = lds_byte(wr * 64 + fr, fq * 8), boff = lds_byte(wc * 32 + fr, fq * 8);
#define PG8_SETOFF(G, u) do { _Pragma("unroll") for (int _h = 0; _h < 2; ++_h) _Pragma("unroll") for (int _i = 0; _i < 2; ++_i) { \
        int _row = _h * HALF + RA[_i]; if constexpr (GATHER) { _row = (_row < (u).nrows) ? (u).ridx[_row] : 0; } \
        G[_h][_i] = (unsigned)(_row * lda + CA[_i]) * 2u; } } while (0)
#define PG8_AP(u, t) (((MIDK && (t) >= ksplit) ? (u).a2 : (u).a) + (size_t)(t) * kstep)
#define PG8_BP(u, t) (((BSPLIT && (t) >= ksplit) ? (u).b2 : (u).b) + (size_t)(t) * kstep)
#define PG8_SA(b, h) (((b) * 2 + (h)) * HTB)
#define PG8_SB(b, h) ((4 + (b) * 2 + (h)) * HTB)
#define PG8_ST2(bufoff, p0, p1) do { __builtin_amdgcn_global_load_lds((const unsigned*)(p0), (LAS unsigned*)(lds + (bufoff) + ldsw), 16, 0, 0); \
        __builtin_amdgcn_global_load_lds((const unsigned*)(p1), (LAS unsigned*)(lds + (bufoff) + ldsw + 8192), 16, 0, 0); } while (0)
#define PG8_STAGE_B(bufoff, gb) PG8_ST2(bufoff, (gb) + voffB[0], (gb) + voffB[1])
#define PG8_STAGE_AC(bufoff, ga, h) PG8_ST2(bufoff, (ga) + cG[h][0], (ga) + cG[h][1])
#define PG8_STAGE_AS(bufoff, ga, h) PG8_ST2(bufoff, (ga) + (last ? nG[h][0] : cG[h][0]), (ga) + (last ? nG[h][1] : cG[h][1]))
#define PG8_LDA(dst, b, h) do { _Pragma("unroll") for (int m = 0; m < 4; ++m) _Pragma("unroll") for (int k = 0; k < 2; ++k) dst[m][k] = *(const LAS bf16x8*)(lds + PG8_SA(b, h) + aoff + m * 2048 + k * 1024); } while (0)
#define PG8_LDB(dst, b, h) do { _Pragma("unroll") for (int n = 0; n < 2; ++n) _Pragma("unroll") for (int k = 0; k < 2; ++k) dst[n][k] = *(const LAS bf16x8*)(lds + PG8_SB(b, h) + boff + n * 2048 + k * 1024); } while (0)
#define PG8_MMA(ai, bj, At, Bt) do { __builtin_amdgcn_s_setprio(1); _Pragma("unroll") for (int m = 0; m < 4; ++m) _Pragma("unroll") for (int n = 0; n < 2; ++n) _Pragma("unroll") for (int k = 0; k < 2; ++k) \
        acc[ai][bj][m][n] = __builtin_amdgcn_mfma_f32_16x16x32_bf16(Bt[n][k], At[m][k], acc[ai][bj][m][n], 0, 0, 0); __builtin_amdgcn_s_setprio(0); } while (0)
#define PG8_WAIT_V(n) asm volatile("s_waitcnt vmcnt(" #n ")" ::: "memory")
#define PG8_WAIT_L(n) asm volatile("s_waitcnt lgkmcnt(" #n ")" ::: "memory")
#define PG8_BAR __builtin_amdgcn_s_barrier()
#define PG8_SCHED __builtin_amdgcn_sched_barrier(0)
    Unit cur, nxt; int ui = 0;
    if (!S.next(0, cur)) return;
    f32x4 acc[2][2][4][2];
#pragma unroll
    for (int a = 0; a < 2; ++a)
#pragma unroll
        for (int b = 0; b < 2; ++b)
#pragma unroll
            for (int m = 0; m < 4; ++m)
#pragma unroll
                for (int n = 0; n < 2; ++n) acc[a][b][m][n] = (f32x4){0.f, 0.f, 0.f, 0.f};
    bf16x8 At[4][2], B0[2][2], B1[2][2];
    S.a_ready(cur, wid, lane);
    PG8_SETOFF(cG, cur);
    {
        const char* a0 = PG8_AP(cur, 0); const char* a1 = PG8_AP(cur, 1); const char* cB = PG8_BP(cur, 0);
        PG8_STAGE_B(PG8_SB(0, 0), cB); PG8_STAGE_B(PG8_SB(0, 1), cB + hstepB); PG8_STAGE_AC(PG8_SA(0, 0), a0, 0); PG8_STAGE_AC(PG8_SA(0, 1), a0, 1);
        if (wr == 1) PG8_BAR;
        PG8_WAIT_V(2); PG8_BAR;
        PG8_STAGE_B(PG8_SB(1, 0), cB + kstep); PG8_STAGE_AC(PG8_SA(1, 0), a1, 0); PG8_STAGE_B(PG8_SB(1, 1), cB + hstepB + kstep);
        PG8_WAIT_V(6); PG8_BAR;
    }
    for (;;) {
        const bool has_next = S.next(ui + 1, nxt);
        if (!has_next) nxt = cur;
        if constexpr (GATHER) { PG8_SETOFF(nG, nxt); }
        for (int t = 0; t < nt; t += 2) {
            const bool last = (t == nt - 2);
            if (last && has_next) S.a_ready(nxt, wid, lane);
            if constexpr (MIDK) { if (t == ksplit) E.mid(acc, cur, wr, wc, fr, fq); }
            const char* a1 = PG8_AP(cur, t + 1);
            const char* a2 = last ? PG8_AP(nxt, 0) : PG8_AP(cur, t + 2); const char* b2 = last ? PG8_BP(nxt, 0) : PG8_BP(cur, t + 2);
            const char* a3 = last ? PG8_AP(nxt, 1) : PG8_AP(cur, t + 3); const char* b3 = b2 + kstep;
            PG8_LDB(B0, 0, 0); PG8_LDB(B1, 0, 1); PG8_SCHED; PG8_LDA(At, 0, 0); PG8_STAGE_AC(PG8_SA(1, 1), a1, 1);
            PG8_WAIT_V(8); PG8_WAIT_L(0); PG8_BAR; PG8_MMA(0, 0, At, B0); PG8_MMA(0, 1, At, B1); PG8_BAR; PG8_SCHED;
            PG8_LDA(At, 0, 1); PG8_STAGE_B(PG8_SB(0, 0), b2); PG8_STAGE_B(PG8_SB(0, 1), b2 + hstepB);
            if constexpr (GATHER) { PG8_STAGE_AS(PG8_SA(0, 0), a2, 0); } else { PG8_STAGE_AC(PG8_SA(0, 0), a2, 0); }
            PG8_WAIT_V(8); PG8_WAIT_L(0); PG8_BAR; PG8_MMA(1, 0, At, B0); PG8_MMA(1, 1, At, B1); PG8_BAR; PG8_SCHED;
            PG8_LDB(B0, 1, 0); PG8_LDB(B1, 1, 1); PG8_SCHED; PG8_LDA(At, 1, 0);
            if constexpr (GATHER) { PG8_STAGE_AS(PG8_SA(0, 1), a2, 1); } else { PG8_STAGE_AC(PG8_SA(0, 1), a2, 1); }
            PG8_WAIT_V(8); PG8_WAIT_L(0); PG8_BAR; PG8_MMA(0, 0, At, B0); PG8_MMA(0, 1, At, B1); PG8_BAR; PG8_SCHED;
            PG8_LDA(At, 1, 1); PG8_STAGE_B(PG8_SB(1, 0), b3); PG8_STAGE_B(PG8_SB(1, 1), b3 + hstepB);
            if constexpr (GATHER) { PG8_STAGE_AS(PG8_SA(1, 0), a3, 0); } else { PG8_STAGE_AC(PG8_SA(1, 0), a3, 0); }
            PG8_WAIT_V(8); PG8_WAIT_L(0); PG8_BAR; PG8_MMA(1, 0, At, B0); PG8_MMA(1, 1, At, B1); PG8_BAR; PG8_SCHED;
        }
        if (wr == 0) PG8_BAR;
        E(acc, cur, wr, wc, fr, fq);
        S.done(cur, lane);
        if (!has_next) break;
#pragma unroll
        for (int a = 0; a < 2; ++a)
#pragma unroll
            for (int b = 0; b < 2; ++b)
#pragma unroll
                for (int m = 0; m < 4; ++m)
#pragma unroll
                    for (int n = 0; n < 2; ++n) acc[a][b][m][n] = (f32x4){0.f, 0.f, 0.f, 0.f};
        cur = nxt; ++ui;
        if constexpr (GATHER) {
#pragma unroll
            for (int h = 0; h < 2; ++h)
#pragma unroll
                for (int i = 0; i < 2; ++i) cG[h][i] = nG[h][i]; }
        if (wr == 1) PG8_BAR;
    }
    PG8_WAIT_V(0);
    PG8_BAR;
#undef PG8_SETOFF
#undef PG8_AP
#undef PG8_BP
#undef PG8_SA
#undef PG8_SB
#undef PG8_ST2
#undef PG8_STAGE_B
#undef PG8_STAGE_AC
#undef PG8_STAGE_AS
#undef PG8_LDA
#undef PG8_LDB
#undef PG8_MMA
#undef PG8_WAIT_V
#undef PG8_WAIT_L
#undef PG8_BAR
#undef PG8_SCHED
}

struct DenseOrder {
    const char* A; const char* A2; const char* B; size_t tstepA, tstepB; int nM, nN, nwg, G, c;
    unsigned* wait_cnt; unsigned need; unsigned* pub_cnt; unsigned* tmo;
    __device__ bool next(int i, Unit& u) const {
        const long L = (long)i * G + c; if (L >= nwg) return false;
        int wgid = (int)L; { const int q = nwg / NXCD, r = nwg % NXCD, xcd = wgid % NXCD, off = wgid / NXCD; wgid = (xcd < r ? xcd * (q + 1) : r * (q + 1) + (xcd - r) * q) + off; }
        const int nig = WGM * nN, gid = wgid / nig, fm = gid * WGM, gsz = (nM - fm) < WGM ? (nM - fm) : WGM;
        u.pm = fm + ((wgid % nig) % gsz); u.pn = (wgid % nig) / gsz;
        u.a = A + (size_t)u.pm * tstepA; u.a2 = A2 + (size_t)u.pm * tstepA; u.b = B + (size_t)u.pn * tstepB; u.b2 = u.b; u.ridx = nullptr; u.nrows = 0; u.e = 0; u.lt = 0; return true;
    }
    __device__ __forceinline__ void a_ready(const Unit& u, int wid, int lane) const {
        if (wait_cnt) {
            if (wid == 0) { unsigned polls = 0;
                while ((unsigned)__builtin_amdgcn_readfirstlane(__hip_atomic_load(wait_cnt + 64 * u.pm, __ATOMIC_RELAXED, __HIP_MEMORY_SCOPE_AGENT)) < need) {
                    if (++polls > (1u << 20)) { if (lane == 0) __hip_atomic_store(tmo, 1u, __ATOMIC_RELAXED, __HIP_MEMORY_SCOPE_AGENT); break; }
                    __builtin_amdgcn_s_sleep(2); }
                __builtin_amdgcn_fence(__ATOMIC_ACQUIRE, "agent");
                asm volatile("s_waitcnt vmcnt(0)" ::: "memory"); }
            asm volatile("" ::: "memory"); __builtin_amdgcn_s_barrier(); asm volatile("" ::: "memory");
        }
    }
    __device__ __forceinline__ void done(const Unit& u, int lane) const {
        if (pub_cnt) { asm volatile("s_waitcnt vmcnt(0)" ::: "memory");
            if (lane == 0) __hip_atomic_fetch_add(pub_cnt + 64 * u.pm, 1u, __ATOMIC_RELAXED, __HIP_MEMORY_SCOPE_AGENT); }
    }
};
__device__ __forceinline__ void pair_of(int cl, int& ea, int& eb) { const int g = cl / 6, pi = cl - g * 6; const int a = pi < 3 ? 0 : (pi < 5 ? 1 : 2), b = pi < 3 ? pi + 1 : (pi < 5 ? pi - 1 : 3); ea = g * 4 + a; eb = g * 4 + b; }
__device__ __forceinline__ int class_of_tile(const LAS int* tb, int tau) { int c = 0;
#pragma unroll
    for (int j = 1; j < NCLS; ++j) c = (tau >= tb[j]) ? j : c;
    return c; }
struct MoeOrder1 {
    const LAS int* tb; const unsigned* cnt; const char* H2; const char* WGU; const int* TOK; int G, c;
    __device__ bool next(int i, Unit& u) const {
        const int L = i * G + c; const int tau = L >> 3; if (tau >= tb[NCLS]) return false;
        const int cl = class_of_tile(tb, tau), lt = tau - tb[cl]; int ea, eb; pair_of(cl, ea, eb);
        u.pm = tau; u.pn = L & 7; u.e = cl; u.lt = lt; u.nrows = (int)cnt[cl] - lt * 256; u.ridx = TOK + (size_t)cl * T + lt * 256;
        u.a = H2; u.a2 = H2; u.b = WGU + (size_t)((u.pn < 4) ? ea : eb) * ((size_t)1024 * D * 2) + (size_t)(u.pn & 3) * ((size_t)256 * D * 2); u.b2 = u.b; return true;
    }
    unsigned* tcnt;
    __device__ __forceinline__ void a_ready(const Unit&, int, int) const {}
    __device__ __forceinline__ void done(const Unit& u, int lane) const {
        asm volatile("s_waitcnt vmcnt(0)" ::: "memory");
        if (lane == 0) __hip_atomic_fetch_add(tcnt + 64 * u.pm, 1u, __ATOMIC_RELAXED, __HIP_MEMORY_SCOPE_AGENT);
    }
};
struct MoeOrder2 {
    const LAS int* tb; const unsigned* cnt; const char* ACT; const char* WD; const int* TOK; int G, c;
    __device__ bool next(int i, Unit& u) const {
        const int L = i * G + c; const int tau = L >> 2; if (tau >= tb[NCLS]) return false;
        const int cl = class_of_tile(tb, tau), lt = tau - tb[cl]; int ea, eb; pair_of(cl, ea, eb);
        u.pm = tau; u.pn = L & 3; u.e = cl; u.lt = lt; u.nrows = (int)cnt[cl] - lt * 256; u.ridx = TOK + (size_t)cl * T + lt * 256;
        u.a = ACT + (size_t)tau * ((size_t)256 * 1024 * 2); u.a2 = u.a;
        u.b = WD + (size_t)ea * ((size_t)1024 * DE * 2) + (size_t)u.pn * ((size_t)256 * DE * 2);
        u.b2 = WD + (size_t)eb * ((size_t)1024 * DE * 2) + (size_t)u.pn * ((size_t)256 * DE * 2) - (size_t)8 * 128; return true;
    }
    unsigned* tcnt; unsigned* tmo;
    __device__ __forceinline__ void a_ready(const Unit& u, int wid, int lane) const {
        if (wid == 0) {
            unsigned polls = 0;
            while ((unsigned)__builtin_amdgcn_readfirstlane(__hip_atomic_load(tcnt + 64 * u.pm, __ATOMIC_RELAXED, __HIP_MEMORY_SCOPE_AGENT)) < 64u) {
                if (++polls > (1u << 20)) { if (lane == 0) __hip_atomic_store(tmo, 1u, __ATOMIC_RELAXED, __HIP_MEMORY_SCOPE_AGENT); break; }
                __builtin_amdgcn_s_sleep(2); }
            __builtin_amdgcn_fence(__ATOMIC_ACQUIRE, "agent");
            asm volatile("s_waitcnt vmcnt(0)" ::: "memory");
        }
        asm volatile("" ::: "memory"); __builtin_amdgcn_s_barrier(); asm volatile("" ::: "memory");
    }
    __device__ __forceinline__ void done(const Unit&, int) const {}
};
}

using pg8::Unit;
typedef f32x4 AccT[2][2][4][2];
#define OPAQUE(x) asm volatile("" : "+v"(x))
struct EpiInProj {
    static constexpr int PERM = 2;
    bf16 *d0, *d1, *d2, *d3, *d4, *d5, *d6; const float* qg; const float* kg; float* vstatp; LAS float* tab;
    __device__ __forceinline__ void operator()(const AccT& acc, const Unit& u, int wr, int wc, int fr, int fq) const {
        const int seg = u.pn >> 2; char* base = (char*)(seg == 0 ? d0 : seg == 1 ? d1 : seg == 2 ? d2 : seg == 3 ? d3 : seg == 4 ? d4 : seg == 5 ? d5 : d6);
        unsigned ob = (unsigned)((u.pm * 256 + wr * 64 + (fr & ~1)) * D + (u.pn & 3) * 256 + wc * 64) * 2u + (unsigned)((fr & 1) * 64 + fq * 16); OPAQUE(ob);
        if (seg >= 5) {
            unsigned og = (unsigned)((u.pm * 256 + wr * 64 + fr) * D + (u.pn - 20) * 128 + wc * 32 + 8 * fq) * 2u; OPAQUE(og);
#pragma unroll
            for (int ai = 0; ai < 2; ++ai)
#pragma unroll
                for (int m = 0; m < 4; ++m) { const unsigned o = og + (unsigned)((ai * 128 + m * 16) * D * 2);
                    const f32x4 ea0 = exp2_4(acc[ai][0][m][0] * (-LOG2E)) + 1.0f, ea1 = exp2_4(acc[ai][0][m][1] * (-LOG2E)) + 1.0f;
                    const f32x4 eb0 = exp2_4(acc[ai][1][m][0] * (-LOG2E)) + 1.0f, eb1 = exp2_4(acc[ai][1][m][1] * (-LOG2E)) + 1.0f;
                    const f32x4 r0 = eb0 * rcp_4(ea0), r1 = eb1 * rcp_4(ea1), s0 = rcp_4(eb0), s1 = rcp_4(eb1);
                    u32x4 w; w.x = cvt_pk_bf16(r0[0], r0[1]); w.y = cvt_pk_bf16(r0[2], r0[3]); w.z = cvt_pk_bf16(r1[0], r1[1]); w.w = cvt_pk_bf16(r1[2], r1[3]);
                    __builtin_nontemporal_store(w, (u32x4*)((char*)d5 + o));
                    w.x = cvt_pk_bf16(s0[0], s0[1]); w.y = cvt_pk_bf16(s0[2], s0[3]); w.z = cvt_pk_bf16(s1[0], s1[1]); w.w = cvt_pk_bf16(s1[2], s1[3]);
                    __builtin_nontemporal_store(w, (u32x4*)((char*)d6 + o)); }
            return;
        }
        if (seg == 0 || seg == 4) {
            const bool odd = (fr & 1) != 0;
#pragma unroll
            for (int ai = 0; ai < 2; ++ai)
#pragma unroll
                for (int m = 0; m < 4; ++m) { const unsigned o = ob + (unsigned)((ai * 128 + m * 16) * D * 2);
                    u32x4 w[2];
#pragma unroll
                    for (int bj = 0; bj < 2; ++bj) { f32x4 v0 = acc[ai][bj][m][0], v1 = acc[ai][bj][m][1];
                        if (seg == 0) { v0 = gelu4(v0); v1 = gelu4(v1); }
                        w[bj].x = cvt_pk_bf16(v0[0], v0[1]); w[bj].y = cvt_pk_bf16(v0[2], v0[3]); w[bj].z = cvt_pk_bf16(v1[0], v1[1]); w[bj].w = cvt_pk_bf16(v1[2], v1[3]); }
                    st_lines<true>(base + o, D * 2, w[0], w[1], odd); }
            return;
        }
        if (seg == 1) stat_tile<true>(acc, u, wr, wc, fr, fq, base, ob, seg); else stat_tile<false>(acc, u, wr, wc, fr, fq, base, ob, seg);
    }
    template <bool GELU> __device__ __forceinline__ void stat_tile(const AccT& acc, const Unit& u, int wr, int wc, int fr, int fq, char* base, unsigned ob, int seg) const {
        int fr_ = fr, fq_ = fq; OPAQUE(fr_); OPAQUE(fq_);
        const int rowl = wr * 64 + fr_;
        const bool odd = (fr_ & 1) != 0;
        const int tslot = GELU ? wc : ((wc >> 1) * 1024 + (wc & 1) * 2);
        f32x4 g00, g01, g10, g11;
        if constexpr (!GELU) { const float* gv = (seg == 2 ? qg : kg) + (wc & 1) * 64 + 8 * fq_; const float gs = (seg == 2) ? QSCALE : 1.0f;
            g00 = *(const f32x4*)gv * gs; g01 = *(const f32x4*)(gv + 4) * gs; g10 = *(const f32x4*)(gv + 32) * gs; g11 = *(const f32x4*)(gv + 36) * gs; }
#pragma unroll
        for (int ai = 0; ai < 2; ++ai)
#pragma unroll
            for (int m = 0; m < 4; ++m) { const unsigned o = ob + (unsigned)((ai * 128 + m * 16) * D * 2);
                u32x4 w[2];
#pragma unroll
                for (int bj = 0; bj < 2; ++bj) { f32x4 v0 = acc[ai][bj][m][0], v1 = acc[ai][bj][m][1];
                    if constexpr (GELU) {
                        v0 = gelu4(v0); v1 = gelu4(v1);
                        w[bj].x = cvt_pk_bf16(v0[0], v0[1]); w[bj].y = cvt_pk_bf16(v0[2], v0[3]); w[bj].z = cvt_pk_bf16(v1[0], v1[1]); w[bj].w = cvt_pk_bf16(v1[2], v1[3]); }
                    float sq = (v0[0] * v0[0] + v0[1] * v0[1]) + (v0[2] * v0[2] + v0[3] * v0[3]) + (v1[0] * v1[0] + v1[1] * v1[1]) + (v1[2] * v1[2] + v1[3] * v1[3]);
                    sq = rows_sum(sq);
                    if (fq_ == 0) tab[(GELU ? bj * 1024 : bj) + (ai * 128 + m * 16 + rowl) * 4 + tslot] = sq; }
                if constexpr (GELU) st_lines<true>(base + o, D * 2, w[0], w[1], odd); }
        asm volatile("s_waitcnt lgkmcnt(0)" ::: "memory"); __builtin_amdgcn_s_barrier(); asm volatile("" ::: "memory");
        if constexpr (GELU) {
            if (wc == 0 && fq_ == 0) {
#pragma unroll
                for (int ai = 0; ai < 2; ++ai)
#pragma unroll
                    for (int m = 0; m < 4; ++m) { const int rl = ai * 128 + m * 16 + rowl;
                        const f32x4 t0 = *(const LAS f32x4*)(tab + (rl) * 4), t1 = *(const LAS f32x4*)(tab + (256 + rl) * 4);
                        vstatp[(size_t)(u.pn & 3) * T + u.pm * 256 + rl] = ((t0.x + t0.y) + (t0.z + t0.w)) + ((t1.x + t1.y) + (t1.z + t1.w)); } }
        } else {
#pragma unroll
            for (int ai = 0; ai < 2; ++ai)
#pragma unroll
                for (int m = 0; m < 4; ++m) { const unsigned o = ob + (unsigned)((ai * 128 + m * 16) * D * 2);
                    const int rl = ai * 128 + m * 16 + rowl;
                    const f32x4 t0 = *(const LAS f32x4*)(tab + ((wc >> 1) * 256 + rl) * 4);
                    const float rr = 1.0f / sqrtf(((t0.x + t0.y) + (t0.z + t0.w)) * (1.0f / DH) + EPS);
                    const f32x4 a0 = acc[ai][0][m][0] * rr * g00, a1 = acc[ai][0][m][1] * rr * g01, b0 = acc[ai][1][m][0] * rr * g10, b1 = acc[ai][1][m][1] * rr * g11;
                    u32x4 w0, w1; w0.x = cvt_pk_bf16(a0[0], a0[1]); w0.y = cvt_pk_bf16(a0[2], a0[3]); w0.z = cvt_pk_bf16(a1[0], a1[1]); w0.w = cvt_pk_bf16(a1[2], a1[3]);
                    w1.x = cvt_pk_bf16(b0[0], b0[1]); w1.y = cvt_pk_bf16(b0[2], b0[3]); w1.z = cvt_pk_bf16(b1[0], b1[1]); w1.w = cvt_pk_bf16(b1[2], b1[3]);
                    st_lines<true>(base + o, D * 2, w0, w1, odd);
                    asm volatile("" ::: "memory"); }
        }
    }
};
struct EpiProjAB {
    static constexpr int PERM = 2;
    const bf16* SA; const bf16* SB; bf16* MG;
    __device__ __forceinline__ void mid(AccT& acc, const Unit& u, int wr, int wc, int fr, int fq) const {
        unsigned ob = (unsigned)((u.pm * 256 + wr * 64 + (fr & ~1)) * D + u.pn * 256 + wc * 64) * 2u + (unsigned)((fr & 1) * 64 + fq * 16); OPAQUE(ob);
        const bool odd = (fr & 1) != 0;
#pragma unroll
        for (int ai = 0; ai < 2; ++ai)
#pragma unroll
            for (int m = 0; m < 4; ++m) { const unsigned o = ob + (unsigned)((ai * 128 + m * 16) * D * 2);
                u32x4 av[2]; ld_lines_fix(*(const u32x4*)((const char*)SA + o), *(const u32x4*)((const char*)SA + o + D * 2), odd, av[0], av[1]);
#pragma unroll
                for (int bj = 0; bj < 2; ++bj) { const u32x4 a = av[bj];
                    f32x4& v0 = acc[ai][bj][m][0]; f32x4& v1 = acc[ai][bj][m][1];
                    v0[0] *= bflo(a.x); v0[1] *= bfhi(a.x); v0[2] *= bflo(a.y); v0[3] *= bfhi(a.y);
                    v1[0] *= bflo(a.z); v1[1] *= bfhi(a.z); v1[2] *= bflo(a.w); v1[3] *= bfhi(a.w); }
                if (m == 3) asm volatile("" ::: "memory"); }
    }
    __device__ __forceinline__ void operator()(const AccT& acc, const Unit& u, int wr, int wc, int fr, int fq) const {
        unsigned os = (unsigned)((u.pm * 256 + wr * 64 + (fr & ~1)) * D + u.pn * 256 + wc * 64) * 2u + (unsigned)((fr & 1) * 64 + fq * 16); OPAQUE(os);
        const bool odd = (fr & 1) != 0;
#pragma unroll
        for (int ai = 0; ai < 2; ++ai) {
            u32x4 bv[4][2];
#pragma unroll
            for (int m = 0; m < 4; ++m)
#pragma unroll
                for (int bj = 0; bj < 2; ++bj) bv[m][bj] = *(const u32x4*)((const char*)SB + os + (unsigned)((ai * 128 + m * 16 + bj) * D * 2));
#pragma unroll
            for (int m = 0; m < 4; ++m) { u32x4 w[2], bb[2]; ld_lines_fix(bv[m][0], bv[m][1], odd, bb[0], bb[1]);
#pragma unroll
                for (int bj = 0; bj < 2; ++bj) { const u32x4 b = bb[bj]; const f32x4 v0 = acc[ai][bj][m][0], v1 = acc[ai][bj][m][1];
                    w[bj].x = cvt_pk_bf16(v0[0] * bflo(b.x), v0[1] * bfhi(b.x)); w[bj].y = cvt_pk_bf16(v0[2] * bflo(b.y), v0[3] * bfhi(b.y));
                    w[bj].z = cvt_pk_bf16(v1[0] * bflo(b.z), v1[1] * bfhi(b.z)); w[bj].w = cvt_pk_bf16(v1[2] * bflo(b.w), v1[3] * bfhi(b.w)); }
                st_lines_wt(MG, os + (unsigned)((ai * 128 + m * 16) * D * 2), D * 2, w[0], w[1], odd); }
            asm volatile("" ::: "memory"); }
    }
};
struct EpiOut {
    static constexpr int PERM = 2;
    const float* x; const float* mod; bf16* x1;
    __device__ __forceinline__ void operator()(const AccT& acc, const Unit& u, int wr, int wc, int fr, int fq) const {
        int col0 = u.pn * 256 + wc * 64 + 8 * fq; OPAQUE(col0);
        unsigned ob = (unsigned)((u.pm * 256 + wr * 64 + fr) * D + col0) * 4u; OPAQUE(ob);
        unsigned os = (unsigned)((u.pm * 256 + wr * 64 + (fr & ~1)) * D + u.pn * 256 + wc * 64) * 2u + (unsigned)((fr & 1) * 64 + fq * 16); OPAQUE(os);
        const bool odd = (fr & 1) != 0;
        const float* gate = (const float*)((const char*)mod + (unsigned)((((u.pm * 256) >> 11) * 6144 + 2048 + col0) * 4));
        f32x4 g[2][2];
#pragma unroll
        for (int bj = 0; bj < 2; ++bj)
#pragma unroll
            for (int n = 0; n < 2; ++n) g[bj][n] = *(const f32x4*)(gate + bj * 32 + n * 4);
#pragma unroll
        for (int ai = 0; ai < 2; ++ai) {
            f32x4 xv[4][2][2];
#pragma unroll
            for (int m = 0; m < 4; ++m)
#pragma unroll
                for (int bj = 0; bj < 2; ++bj)
#pragma unroll
                    for (int n = 0; n < 2; ++n) xv[m][bj][n] = *(const f32x4*)((const char*)x + ob + (unsigned)((ai * 128 + m * 16) * D * 4) + bj * 128 + n * 16);
#pragma unroll
            for (int m = 0; m < 4; ++m) { u32x4 w[2];
#pragma unroll
                for (int bj = 0; bj < 2; ++bj) { const f32x4 r0 = xv[m][bj][0] + g[bj][0] * acc[ai][bj][m][0], r1 = xv[m][bj][1] + g[bj][1] * acc[ai][bj][m][1];
                    w[bj].x = cvt_pk_bf16(r0[0], r0[1]); w[bj].y = cvt_pk_bf16(r0[2], r0[3]); w[bj].z = cvt_pk_bf16(r1[0], r1[1]); w[bj].w = cvt_pk_bf16(r1[2], r1[3]); }
                st_lines_wt(x1, os + (unsigned)((ai * 128 + m * 16) * D * 2), D * 2, w[0], w[1], odd); }
            asm volatile("" ::: "memory"); }
    }
};
struct EpiMoe1 {
    static constexpr int PERM = 1;
    bf16* ACT; const float* WW;
    __device__ __forceinline__ void operator()(const AccT& acc, const Unit& u, int wr, int wc, int fr, int fq) const {
        const int half = u.pn >> 2;
        unsigned ob = (unsigned)((u.pm * 256 + wr * 64 + fr) * 1024 + half * 512 + (u.pn & 3) * 128 + wc * 32 + 8 * fq) * 2u; OPAQUE(ob);
        const float* wl = WW + ((size_t)u.e * T + u.lt * 256) * 2 + half;
        int fr_ = fr; OPAQUE(fr_);
#pragma unroll
        for (int ai = 0; ai < 2; ++ai)
#pragma unroll
            for (int m = 0; m < 4; ++m) { const int lr = ai * 128 + wr * 64 + m * 16 + fr_; const float w = (lr < u.nrows) ? *(const float*)((const char*)wl + (unsigned)lr * 8u) : 0.f;
                const f32x4 g0 = acc[ai][0][m][0], g1 = acc[ai][0][m][1];
                const f32x4 a0 = g0 * sigmoid4(g0) * (acc[ai][1][m][0] * w), a1 = g1 * sigmoid4(g1) * (acc[ai][1][m][1] * w);
                u32x4 ww; ww.x = cvt_pk_bf16(a0[0], a0[1]); ww.y = cvt_pk_bf16(a0[2], a0[3]); ww.z = cvt_pk_bf16(a1[0], a1[1]); ww.w = cvt_pk_bf16(a1[2], a1[3]);
                st16_wt(ACT, ob + (unsigned)((ai * 128 + m * 16) * 1024 * 2), ww); }
    }
};
struct EpiMoe2 {
    static constexpr int PERM = 0;
    float* out; const float* mod; const bf16* x1;
    __device__ __forceinline__ void operator()(const AccT& acc, const Unit& u, int wr, int wc, int fr, int fq) const {
        int col0 = u.pn * 256 + wc * 32 + 4 * fq; OPAQUE(col0);
        int colx = u.pn * 256 + wc * 32 + 8 * (fq >> 1) + 16 * (fq & 1); OPAQUE(colx);
        int fr_ = fr; OPAQUE(fr_);
        const bool odd = (fr_ & 1) != 0;
        int tok[2][4];
#pragma unroll
        for (int ai = 0; ai < 2; ++ai)
#pragma unroll
            for (int m = 0; m < 4; ++m) { const int lr = ai * 128 + wr * 64 + m * 16 + fr_; tok[ai][m] = (lr < u.nrows) ? *(const int*)((const char*)u.ridx + (unsigned)lr * 4u) : -1; }
#pragma unroll
        for (int ai = 0; ai < 2; ++ai) {
            u32x4 xl[4][2];
#pragma unroll
            for (int m = 0; m < 4; ++m) { const bf16* xp = x1 + (size_t)(tok[ai][m] < 0 ? 0 : tok[ai][m]) * D + colx;
#pragma unroll
                for (int bj = 0; bj < 2; ++bj) xl[m][bj] = *(const u32x4*)(xp + bj * 128); }
#pragma unroll
            for (int m = 0; m < 4; ++m) { const int tk = tok[ai][m]; const int tn = (int)dpp_swap1((unsigned)tk); const int te = odd ? tn : tk, to = odd ? tk : tn;
                const float* gp = mod + (size_t)((tk < 0 ? 0 : tk) >> 11) * 6144 + 5120 + col0;
                float* pe = out + (size_t)(te < 0 ? 0 : te) * D + col0 + (odd ? 16 : 0); float* po = out + (size_t)(to < 0 ? 0 : to) * D + col0 + (odd ? 16 : 0);
#pragma unroll
                for (int bj = 0; bj < 2; ++bj) { const f32x4 g0 = *(const f32x4*)(gp + bj * 128), g1 = *(const f32x4*)(gp + bj * 128 + 16);
                    const auto s0 = __builtin_amdgcn_permlane16_swap(xl[m][bj].x, xl[m][bj].z, false, false); const auto s1 = __builtin_amdgcn_permlane16_swap(xl[m][bj].y, xl[m][bj].w, false, false);
                    const f32x4 x0 = {bflo(s0[0]), bfhi(s0[0]), bflo(s1[0]), bfhi(s1[0])}, x1v = {bflo(s0[1]), bfhi(s0[1]), bflo(s1[1]), bfhi(s1[1])};
                    const u32x4 r0 = __builtin_bit_cast(u32x4, x0 + g0 * acc[ai][bj][m][0]), r1 = __builtin_bit_cast(u32x4, x1v + g1 * acc[ai][bj][m][1]);
                    const u32x4 x = odd ? r0 : r1; u32x4 y; y.x = dpp_swap1(x.x); y.y = dpp_swap1(x.y); y.z = dpp_swap1(x.z); y.w = dpp_swap1(x.w);
                    if (te >= 0) *(u32x4*)(pe + bj * 128) = odd ? y : r0;
                    if (to >= 0) *(u32x4*)(po + bj * 128) = odd ? r1 : y; } }
            asm volatile("" ::: "memory"); }
    }
};

namespace att {
typedef float f32x16 __attribute__((ext_vector_type(16)));
typedef short s16x4 __attribute__((ext_vector_type(4)));
#define KSWZ(row, colB) ((row) * 256 + ((colB) ^ (((row) & 7) << 4)))
__device__ __forceinline__ int crow(int r, int hi) { return (r & 3) + 8 * (r >> 2) + 4 * hi; }
__device__ __forceinline__ int v_st(int k, int c) { const int kk = (k & ~0xC) | ((k & 4) << 1) | ((k & 8) >> 1); return ((kk >> 3) * 4 + (c >> 5)) * 512 + ((kk & 7) * 32 + (c & 31)) * 2; }
__device__ __forceinline__ int v_rd_base(int lane) { return ((lane & 3) << 3) | (((lane >> 2) & 3) << 6) | (((lane >> 4) & 1) << 5) | (((lane >> 5) & 1) << 8); }
constexpr int v_rd_off(int d0, int ks, int half) { return d0 * 512 + ks * 4096 + half * 2048; }
template <int OFF> __device__ __forceinline__ s16x4 tr_read(int vb) {
    s16x4 r; asm volatile("ds_read_b64_tr_b16 %0, %1 offset:%2" : "=&v"(r) : "v"(vb), "i"(OFF) : "memory"); return r;
}
template <int D0> __device__ __forceinline__ void pv_two(f32x16& oa, f32x16& ob2, int vb, bf16x8 pa0, bf16x8 pa1) {
    const s16x4 l0 = tr_read<v_rd_off(D0, 0, 0)>(vb), h0 = tr_read<v_rd_off(D0, 0, 1)>(vb), l1 = tr_read<v_rd_off(D0, 1, 0)>(vb), h1 = tr_read<v_rd_off(D0, 1, 1)>(vb);
    const s16x4 m0 = tr_read<v_rd_off(D0 + 1, 0, 0)>(vb), n0 = tr_read<v_rd_off(D0 + 1, 0, 1)>(vb), m1 = tr_read<v_rd_off(D0 + 1, 1, 0)>(vb), n1 = tr_read<v_rd_off(D0 + 1, 1, 1)>(vb);
    asm volatile("s_waitcnt lgkmcnt(0)" ::: "memory"); __builtin_amdgcn_sched_barrier(0);
#define PKV(L_, H_) (bf16x8){L_[0], L_[1], L_[2], L_[3], H_[0], H_[1], H_[2], H_[3]}
    oa = __builtin_amdgcn_mfma_f32_32x32x16_bf16(pa0, PKV(l0, h0), oa, 0, 0, 0);
    ob2 = __builtin_amdgcn_mfma_f32_32x32x16_bf16(pa0, PKV(m0, n0), ob2, 0, 0, 0);
    oa = __builtin_amdgcn_mfma_f32_32x32x16_bf16(pa1, PKV(l1, h1), oa, 0, 0, 0);
    ob2 = __builtin_amdgcn_mfma_f32_32x32x16_bf16(pa1, PKV(m1, n1), ob2, 0, 0, 0);
#undef PKV
}
template <int MODE>
__device__ __forceinline__ void class_block(f32x16 (&o)[4], float& lsum, const bf16x8 (&qr)[8], int kbase  , int vb  ,
                                            int r32, int hi, int Lq, int rel, int r, int cls, float negM2) {
    f32x16 p;
#pragma unroll
    for (int i = 0; i < 16; ++i) p[i] = negM2;
    int r32_ = r32, hi_ = hi; OPAQUE(r32_); OPAQUE(hi_);
    bf16x8 kf[8];
#pragma unroll
    for (int d0 = 0; d0 < 8; ++d0) { const int cb = (d0 * 16 + hi_ * 8) * 2; kf[d0] = *(const LAS bf16x8*)((LAS unsigned char*)(size_t)0 + kbase + KSWZ(r32_, cb)); }
#pragma unroll
    for (int d0 = 0; d0 < 8; ++d0) p = __builtin_amdgcn_mfma_f32_32x32x16_bf16(kf[d0], qr[d0], p, 0, 0, 0);
    const int Bv = 128 * rel + (r - cls);
    const bool same = (cls == r);
    const int lo1 = -(Bv >> 2), hi1 = (128 - Bv) >> 2;
    const int lo2 = same ? lo1 : 64, hi2 = same ? ((512 - Bv) >> 2) : -64;
    float ls = 0.f;
#pragma unroll
    for (int i = 0; i < 16; ++i) { const int creg = (i & 3) + 8 * (i >> 2); const int Dv = Lq - creg;
        const float e = __builtin_amdgcn_exp2f(p[i]);
        const bool m3 = ((Lq & 3) == (creg & 3));
        float w;
        if constexpr (MODE == 0) { w = m3 ? 1.f : 0.f; }
        else if constexpr (MODE == 2) { w = ((Dv >= lo1) & (Dv <= hi1)) ? 1.f : 0.f; }
        else { w = (((Dv >= lo1) & (Dv <= hi1)) ? 1.f : 0.f) + (((Dv >= lo2) & (Dv <= hi2)) ? 1.f : 0.f) + (((Dv >= lo2) & m3) ? 1.f : 0.f); }
        p[i] = e * w; ls += p[i]; }
    lsum += ls;
    bf16x8 pa0, pa1;
#define PK4(P_, BASE, OUT) do { unsigned a0 = cvt_pk_bf16(P_[BASE + 0], P_[BASE + 1]), a1 = cvt_pk_bf16(P_[BASE + 2], P_[BASE + 3]);   \
        unsigned b0 = cvt_pk_bf16(P_[BASE + 4], P_[BASE + 5]), b1 = cvt_pk_bf16(P_[BASE + 6], P_[BASE + 7]);                              \
        auto r0 = __builtin_amdgcn_permlane32_swap(a0, b0, false, false); auto r1 = __builtin_amdgcn_permlane32_swap(a1, b1, false, false); \
        u32x4 w_ = {r0[0], r1[0], r0[1], r1[1]}; OUT = *reinterpret_cast<bf16x8*>(&w_); } while (0)
    PK4(p, 0, pa0); PK4(p, 8, pa1);
#undef PK4
    pv_two<0>(o[0], o[1], vb, pa0, pa1); pv_two<2>(o[2], o[3], vb, pa0, pa1);
}
__device__ __forceinline__ void attn_phase(const bf16* Kb, const bf16* Vb, bf16* QO, const float* qg, const float* kg, unsigned char* lds_g, int vcu, int G, const int TID) {
    const int tid = TID, wid = __builtin_amdgcn_readfirstlane(tid >> 6), lane = tid & 63, r32 = lane & 31, hi = lane >> 5;
    const int r = wid & 3, hf = wid >> 2;
    const int lds0 = (int)(size_t)(LAS unsigned char*)lds_g;
    float* li_l = (float*)(lds_g + LDS_EPI) + wid * 64;
    float gq = fmaxf(fabsf(qg[lane]), fabsf(qg[lane + 64])), gk = fmaxf(fabsf(kg[lane]), fabsf(kg[lane + 64]));
#pragma unroll
    for (int o_ = 1; o_ < 64; o_ <<= 1) { gq = fmaxf(gq, __shfl_xor(gq, o_)); gk = fmaxf(gk, __shfl_xor(gk, o_)); }
    const float negM2 = -11.313708498984761f * LOG2E * gq * gk;
    const int Lq = r32 - 4 * hi;
    const int sr = tid >> 4, sc = (tid & 15) * 8;
    const int scls = sr & 3;
    for (int it = vcu; it < 1024; it += G) {
        const int j = it & 255, rr = it >> 8, bh = (j >> 3) * 4 + rr, kq = j & 7;
        const int qt = (rr & 1) ? 7 - kq : kq; const bool desc = (rr & 1) != 0;
        const int b = bh >> 3, h = bh & 7, t0 = 256 * qt, cq = 2 * qt + hf, nch = 2 * qt + 2;
        const size_t hb = (size_t)b * S * D + h * DH;
        const bf16* Kh = Kb + hb; const bf16* Vh = Vb + hb; bf16* Qh = QO + hb;
        bf16x8 qr[8];
        { const bf16* Qw = Qh + (size_t)(t0 + 128 * hf + r + 4 * r32) * D + hi * 8;
#pragma unroll
          for (int d0 = 0; d0 < 8; ++d0) qr[d0] = *(const bf16x8*)(Qw + d0 * 16); }
        f32x16 o[4];
#pragma unroll
        for (int d = 0; d < 4; ++d)
#pragma unroll
            for (int i = 0; i < 16; ++i) o[d][i] = 0.f;
        float lsum = 0.f;
#define SDMA(c, bf) do { int ln_ = lane; OPAQUE(ln_); const int cls_ = wid >> 1, w1_ = wid & 1; \
            const unsigned cbase_ = (unsigned)(128 * (c)) * 2048u; \
            _Pragma("unroll") for (int i_ = 0; i_ < 4; ++i_) { \
                const int kidx_ = 16 * w1_ + 4 * i_ + (ln_ >> 4); const int pc_ = (ln_ & 15) ^ (kidx_ & 7); \
                const unsigned ko_ = cbase_ + (unsigned)(4 * kidx_ + cls_) * 2048u + (unsigned)pc_ * 16u; \
                __builtin_amdgcn_global_load_lds((const unsigned*)((const char*)Kh + ko_), (LAS unsigned*)(L3 + (bf) * 65536 + wid * 4096 + i_ * 1024), 16, 0, 0); \
                const int k_ = 16 * w1_ + 8 * ((ln_ >> 4) & 1) + 4 * (i_ >> 1) + ((ln_ >> 2) & 3); const int c_ = 32 * (2 * (i_ & 1) + (ln_ >> 5)) + 8 * (ln_ & 3); \
                const unsigned vo_ = cbase_ + (unsigned)(4 * k_ + cls_) * 2048u + (unsigned)c_ * 2u; \
                __builtin_amdgcn_global_load_lds((const unsigned*)((const char*)Vh + vo_), (LAS unsigned*)(L3 + (bf) * 65536 + 32768 + wid * 4096 + i_ * 1024), 16, 0, 0); } } while (0)
        LAS unsigned char* L3 = (LAS unsigned char*)lds_g;
        SDMA((desc ? nch - 1 : 0), 0); __syncthreads();
        for (int ci = 0; ci < nch; ++ci) {
            const int bf = ci & 1; const int c = desc ? nch - 1 - ci : ci;
            if (ci + 1 < nch) SDMA((desc ? c - 1 : c + 1), bf ^ 1);
            const int rel = cq - c;
            const int kb0 = lds0 + bf * 65536, vb0 = lds0 + bf * 65536 + 32768 + v_rd_base(lane);
            if (rel >= 5) { class_block<0>(o, lsum, qr, kb0 + r * 8192, vb0 + r * 8192, r32, hi, Lq, rel, r, r, negM2); }
            else if (rel >= 0) {
                class_block<1>(o, lsum, qr, kb0 + r * 8192, vb0 + r * 8192, r32, hi, Lq, rel, r, r, negM2);
                if (rel < 2) {
#pragma unroll 1
                    for (int k = 1; k < 4; ++k) { const int cls = (r + k) & 3; class_block<2>(o, lsum, qr, kb0 + cls * 8192, vb0 + cls * 8192, r32, hi, Lq, rel, r, cls, negM2); } }
            }
            __syncthreads();
        }
#undef SDMA
        { const float lt = lsum + __shfl_xor(lsum, 32);
          if (hi == 0) li_l[r32] = lt; }
        asm volatile("s_waitcnt lgkmcnt(0)" ::: "memory");
        unsigned short* ot = (unsigned short*)(lds_g + wid * 8704);
#pragma unroll
        for (int i = 0; i < 16; ++i) { const int q = crow(i, hi); const float rli = __builtin_amdgcn_rcpf(li_l[q]);
#pragma unroll
            for (int d0 = 0; d0 < 4; ++d0) ot[q * 136 + d0 * 32 + r32] = (unsigned short)f2bf(o[d0][i] * rli); }
        asm volatile("s_waitcnt lgkmcnt(0)" ::: "memory");
#pragma unroll
        for (int jj = 0; jj < 8; ++jj) { const int idx = jj * 64 + lane, q = idx >> 4, pc = idx & 15;
            const u32x4 v = *(const u32x4*)(ot + q * 136 + pc * 8);
            *(u32x4*)(Qh + (size_t)(t0 + 128 * hf + r + 4 * q) * D + pc * 8) = v; }
        __syncthreads();
    }
}
#undef KSWZ
}


namespace sgu {
using att::f32x16; using att::s16x4; using att::tr_read; using att::v_rd_base; using att::crow;
template <int KS> __device__ __forceinline__ void kstep(f32x16& a0, f32x16& a1, int vb, const bf16x8 af, int nks) {
    if (KS < nks) {
        const s16x4 l0 = tr_read<KS * 4096>(vb), h0 = tr_read<KS * 4096 + 2048>(vb), l1 = tr_read<KS * 4096 + 512>(vb), h1 = tr_read<KS * 4096 + 2048 + 512>(vb);
        asm volatile("s_waitcnt lgkmcnt(0)" ::: "memory"); __builtin_amdgcn_sched_barrier(0);
#define PKV(L_, H_) (bf16x8){L_[0], L_[1], L_[2], L_[3], H_[0], H_[1], H_[2], H_[3]}
        a0 = __builtin_amdgcn_mfma_f32_32x32x16_bf16(af, PKV(l0, h0), a0, 0, 0, 0);
        a1 = __builtin_amdgcn_mfma_f32_32x32x16_bf16(af, PKV(l1, h1), a1, 0, 0, 0);
#undef PKV
    }
}
__device__ __forceinline__ void sgu_phase(const bf16* GU, const bf16* GV, const float* vstat, const float* gn, const bf16* SW, const float* sgu_b, bf16* SG, unsigned char* lds_g, int vcu, int G, const int TID) {
    const int tid = TID, wid = __builtin_amdgcn_readfirstlane(tid >> 6), lane = tid & 63, r32 = lane & 31, hi = lane >> 5;
    const int tb = wid & 3, ch2 = wid >> 2;
    LAS unsigned char* L3 = (LAS unsigned char*)lds_g;
    const int lds0 = (int)(size_t)L3;
    float* ot = (float*)(lds_g + 65536 + wid * 8704);
    float* rsl = (float*)(lds_g + 135168);
    constexpr int NIT = (T / 128) * 8;
#define GDMA(item, bf) do { const int cj_ = (item) >> 3, g_ = (item) & 7; int ln_ = lane; OPAQUE(ln_); \
        _Pragma("unroll") for (int i_ = 0; i_ < 4; ++i_) { const int sp_ = 4 * wid + i_; \
            const int kk_ = 8 * (sp_ >> 1) + ((ln_ & 31) >> 2); const int k_ = (kk_ & ~0xC) | ((kk_ & 4) << 1) | ((kk_ & 8) >> 1); \
            const int c_ = 32 * (2 * (sp_ & 1) + (ln_ >> 5)) + 8 * (ln_ & 3); \
            const unsigned go_ = (unsigned)((cj_ * 128 + k_) * D + g_ * 128 + c_) * 2u; \
            __builtin_amdgcn_global_load_lds((const unsigned*)((const char*)GV + go_), (LAS unsigned*)(L3 + (bf) * 32768 + sp_ * 1024), 16, 0, 0); } } while (0)
    int it = vcu, bf = 0;
    if (it < NIT) { GDMA(it, 0);
        if (tid < 128) { const float* vp = vstat + (it >> 3) * 128 + tid; rsl[tid] = 1.0f / sqrtf(((vp[0] + vp[T]) + (vp[2 * T] + vp[3 * T])) * (1.0f / D) + EPS); } }
    int g_have = -1; u32x4 wvs[8]; f32x4 bs4[4]; float gn0 = 0.f, gn1 = 0.f;
#pragma unroll
    for (int i = 0; i < 8; ++i) wvs[i] = (u32x4){0u, 0u, 0u, 0u};
#pragma unroll
    for (int i = 0; i < 4; ++i) bs4[i] = (f32x4){0.f, 0.f, 0.f, 0.f};
    for (; it < NIT; it += G, bf ^= 1) {
        __syncthreads();
        const bool more = it + G < NIT;
        const int cj = it >> 3, g = it & 7, row0 = cj * 128;
        if (g != g_have) { g_have = g; const bf16* wrow_ = SW + ((size_t)g * 128 + 32 * tb + r32) * 128 + 8 * hi;
#pragma unroll
            for (int i = 0; i < 8; ++i) wvs[i] = *(const u32x4*)(wrow_ + 16 * i);
#pragma unroll
            for (int i = 0; i < 4; ++i) bs4[i] = *(const f32x4*)(sgu_b + g * 128 + 32 * tb + 8 * i + 4 * hi);
            gn0 = gn[g * 128 + ch2 * 64 + r32]; gn1 = gn[g * 128 + ch2 * 64 + 32 + r32]; }
        f32x4 vn = {0.f, 0.f, 0.f, 0.f};
        if (more && tid < 128) { const float* vp = vstat + ((it + G) >> 3) * 128 + tid; vn = (f32x4){vp[0], vp[T], vp[2 * T], vp[3 * T]}; }
        u32x4 uv[4];
#pragma unroll
        for (int jj = 0; jj < 4; ++jj) { const int idx = jj * 64 + lane, q = idx >> 3, pc = idx & 7; uv[jj] = *(const u32x4*)(GU + (size_t)(row0 + 32 * tb + q) * D + g * 128 + ch2 * 64 + pc * 8); }
        asm volatile("" ::: "memory");
        if (more) GDMA(it + G, bf ^ 1);
        const int nks = 2 * tb + 2;
        f32x16 a0, a1;
#pragma unroll
        for (int i = 0; i < 16; ++i) { a0[i] = 0.f; a1[i] = 0.f; }
        const int vb = lds0 + bf * 32768 + ch2 * 1024 + v_rd_base(lane);
        const float* rsp = rsl + bf * 128 + 8 * hi;
#define KSTEP(KS) do { if (KS < nks) { const u32x4 wv = wvs[KS]; const f32x4 r0 = *(const f32x4*)(rsp + 16 * KS), r1 = *(const f32x4*)(rsp + 16 * KS + 4); \
            u32x4 av; av.x = cvt_pk_bf16(bflo(wv.x) * r0.x, bfhi(wv.x) * r0.y); av.y = cvt_pk_bf16(bflo(wv.y) * r0.z, bfhi(wv.y) * r0.w); \
            av.z = cvt_pk_bf16(bflo(wv.z) * r1.x, bfhi(wv.z) * r1.y); av.w = cvt_pk_bf16(bflo(wv.w) * r1.z, bfhi(wv.w) * r1.w); \
            kstep<KS>(a0, a1, vb, *reinterpret_cast<bf16x8*>(&av), nks); } } while (0)
        KSTEP(0); KSTEP(1); KSTEP(2); KSTEP(3); KSTEP(4); KSTEP(5); KSTEP(6); KSTEP(7);
#undef KSTEP
#pragma unroll
        for (int i4 = 0; i4 < 4; ++i4)
#pragma unroll
            for (int e = 0; e < 4; ++e) { const int i = 4 * i4 + e, q = crow(i, hi); ot[q * 68 + r32] = a0[i] * gn0 + bs4[i4][e]; ot[q * 68 + 32 + r32] = a1[i] * gn1 + bs4[i4][e]; }
        asm volatile("s_waitcnt lgkmcnt(0)" ::: "memory");
#pragma unroll
        for (int jj = 0; jj < 4; ++jj) { const int idx = jj * 64 + lane, q = idx >> 3, pc = idx & 7;
            const f32x4 m0 = *(const f32x4*)(ot + q * 68 + pc * 8), m1 = *(const f32x4*)(ot + q * 68 + pc * 8 + 4);
            const size_t go = (size_t)(row0 + 32 * tb + q) * D + g * 128 + ch2 * 64 + pc * 8;
            const u32x4 u_ = uv[jj];
            u32x4 w; w.x = cvt_pk_bf16(bflo(u_.x) * m0.x, bfhi(u_.x) * m0.y); w.y = cvt_pk_bf16(bflo(u_.y) * m0.z, bfhi(u_.y) * m0.w);
            w.z = cvt_pk_bf16(bflo(u_.z) * m1.x, bfhi(u_.z) * m1.y); w.w = cvt_pk_bf16(bflo(u_.w) * m1.z, bfhi(u_.w) * m1.w);
            *(u32x4*)(SG + go) = w; }
        if (more && tid < 128) rsl[(bf ^ 1) * 128 + tid] = 1.0f / sqrtf(((vn.x + vn.y) + (vn.z + vn.w)) * (1.0f / D) + EPS);
        asm volatile("s_waitcnt lgkmcnt(0)" ::: "memory");
    }
#undef GDMA
    __syncthreads();
}
}

#define XB_TMO      128
#define XB_XCNT(j)  (256  + 64 * (j))
#define XB_XSUB(j)  (1280 + 64 * (j))
#define XB_XGEN(j)  (2304 + 64 * (j))
#define XB_TOP      3328
#define XB_TOPGEN   3392
#define XCD_BAR_WORDS 3456
#define XB_SPIN_CAP (1u << 18)

__device__ __forceinline__ unsigned xb_ld(unsigned* p)              { return __hip_atomic_load(p, __ATOMIC_RELAXED, __HIP_MEMORY_SCOPE_AGENT); }
__device__ __forceinline__ unsigned xb_add(unsigned* p, unsigned v) { return __hip_atomic_fetch_add(p, v, __ATOMIC_RELAXED, __HIP_MEMORY_SCOPE_AGENT); }
__device__ __forceinline__ unsigned xb_xcc_id() { return (unsigned)__builtin_amdgcn_s_getreg((3 << 11) | 20) & 0xFu; }
#define XB_SPIN(cond, bar) do { unsigned _sp = 0; while (cond) { __builtin_amdgcn_s_sleep(1); \
    if ((++_sp & 255u) == 0u) { if (xb_ld(&(bar)[XB_TMO])) break; if (_sp > XB_SPIN_CAP) { atomicAdd(&(bar)[XB_TMO], 1u); break; } } } } while (0)

struct XcdBarrier {
    unsigned* bar; unsigned x;
    volatile LAS unsigned* st;
    bool w0;
};

__device__ __forceinline__ XcdBarrier xcd_barrier_post(unsigned* bar, volatile LAS unsigned* st, bool w0) {
    XcdBarrier b; b.bar = bar; b.x = xb_xcc_id(); b.st = st; b.w0 = w0;
    if (lane_id_fresh() == 0 && b.w0) (void)xb_add(&bar[XB_XCNT(b.x)], 1u);
    return b;
}
__device__ __forceinline__ void xcd_barrier_complete(unsigned* bar, unsigned x, unsigned& nloc, unsigned& nx) {
    const unsigned G = gridDim.x * gridDim.y * gridDim.z;
    unsigned sum, cnt, mine, sp = 0u;
    for (;;) {
        sum = 0u; cnt = 0u; mine = 0u;
#pragma unroll
        for (unsigned j = 0; j < 16; ++j) { const unsigned c = xb_ld(&bar[XB_XCNT(j)]); sum += c; cnt += (c > 0u) ? 1u : 0u; mine = (j == x) ? c : mine; }
        if (sum == G) break;
        __builtin_amdgcn_s_sleep(1);
        if ((++sp & 255u) == 0u) { if (xb_ld(&bar[XB_TMO])) break; if (sp > XB_SPIN_CAP) { atomicAdd(&bar[XB_TMO], 1u); break; } }
    }
    nloc = mine > 0u ? mine : 1u; nx = cnt > 0u ? cnt : 1u;
}

struct NoFill { __device__ __forceinline__ void operator()() const {} };
template <class Fill>
__device__ __forceinline__ void xcd_barrier(const XcdBarrier& b, const Fill& fill) {
    asm volatile("s_waitcnt vmcnt(0)" ::: "memory");
    __syncthreads();
    if (!b.w0) fill();
    if (lane_id_fresh() == 0 && b.w0) {
        unsigned* bar = b.bar;
        __builtin_amdgcn_s_waitcnt(0);
        unsigned nloc = b.st[0], nx = b.st[1];
        if (nloc == 0u) { xcd_barrier_complete(bar, b.x, nloc, nx); b.st[0] = nloc; b.st[1] = nx; }
        const unsigned old = xb_add(&bar[XB_XSUB(b.x)], 1u);
        const unsigned gen = old / nloc;
        if (old + 1u == (gen + 1u) * nloc) {
            __builtin_amdgcn_fence(__ATOMIC_RELEASE, "agent");
            asm volatile("s_waitcnt vmcnt(0)" ::: "memory");
            const unsigned og = xb_add(&bar[XB_TOP], 1u);
            const unsigned tg = og / nx;
            if (og + 1u == (tg + 1u) * nx) xb_add(&bar[XB_TOPGEN], 1u);
            else XB_SPIN(xb_ld(&bar[XB_TOPGEN]) == tg, bar);
            __builtin_amdgcn_fence(__ATOMIC_ACQUIRE, "agent");
            xb_add(&bar[XB_XGEN(b.x)], 1u);
            asm volatile("s_waitcnt vmcnt(0)" ::: "memory");
        } else {
            XB_SPIN(xb_ld(&bar[XB_XGEN(b.x)]) == gen, bar);
            __builtin_amdgcn_fence(__ATOMIC_ACQUIRE, "agent");
            asm volatile("s_waitcnt vmcnt(0)" ::: "memory");
        }
    }
    __syncthreads();
}


struct Ptrs {
    const float *x, *c, *w_ada, *b_ada, *g1, *w_in, *sgn, *sgu_w, *sgu_b, *qg, *kg, *wa, *wb, *wo, *g2, *w_rg, *b_rg, *w_re, *b_re, *wg, *wu, *wd;
    float* out; unsigned char* ws;
};
__device__ __forceinline__ void transpose_item(const float* W, int N, int k0, int n0, bf16* dst  , int ldd, float* scr, int lane) {
    float wv[32];
#pragma unroll
    for (int i = 0; i < 32; ++i) wv[i] = W[(size_t)(k0 + 2 * i + (lane >> 5)) * N + n0 + (lane & 31)];
#pragma unroll
    for (int i = 0; i < 32; ++i) scr[(2 * i + (lane >> 5)) * 33 + (lane & 31)] = wv[i];
    asm volatile("s_waitcnt lgkmcnt(0)" ::: "memory");
    const int c = lane & 7;
#pragma unroll
    for (int j = 0; j < 4; ++j) { const int n = (lane >> 3) + 8 * j; const float* s = scr + (8 * c) * 33 + n;
        u32x4 o; o.x = pk2(s[0 * 33], s[1 * 33]); o.y = pk2(s[2 * 33], s[3 * 33]); o.z = pk2(s[4 * 33], s[5 * 33]); o.w = pk2(s[6 * 33], s[7 * 33]);
        *(u32x4*)(dst + (size_t)n * ldd + 8 * c) = o; }
    asm volatile("s_waitcnt lgkmcnt(0)" ::: "memory");
}


__device__ __forceinline__ void p_mod(const Ptrs& P, unsigned char* lds, int bid, int G, const int TID) {
    float* sc = (float*)lds;
    float* red = sc + 1024 * 16;
    const int tid = TID, wave = tid >> 6, lane = tid & 63, col = lane & 31, kh = lane >> 5;
    float* mod = (float*)(P.ws + WS_MOD);
    if (bid >= 6144 / 32) return;
    for (int i = tid; i < 16 * 1024; i += 512) { const int b = i >> 10, k = i & 1023; const float v = P.c[i]; sc[k * 16 + b] = v / (1.0f + __expf(-v)); }
    __syncthreads();
    for (int item = bid; item < 6144 / 32; item += G) {
        const int n0 = item * 32;
        float acc[16];
#pragma unroll
        for (int b = 0; b < 16; ++b) acc[b] = 0.f;
        for (int k0 = wave * 128 + kh * 64; k0 < wave * 128 + kh * 64 + 64; k0 += 8) {
            float wv[8];
#pragma unroll
            for (int u = 0; u < 8; ++u) wv[u] = P.w_ada[(size_t)(k0 + u) * 6144 + n0 + col];
#pragma unroll
            for (int u = 0; u < 8; ++u) { const f32x4* sp = (const f32x4*)(sc + (k0 + u) * 16);
#pragma unroll
                for (int q = 0; q < 4; ++q) { const f32x4 s4 = sp[q]; acc[4 * q + 0] += s4.x * wv[u]; acc[4 * q + 1] += s4.y * wv[u]; acc[4 * q + 2] += s4.z * wv[u]; acc[4 * q + 3] += s4.w * wv[u]; } }
        }
#pragma unroll
        for (int b = 0; b < 16; ++b) { acc[b] += __shfl_xor(acc[b], 32); if (kh == 0) red[(wave * 16 + b) * 32 + col] = acc[b]; }
        __syncthreads();
        { const int b = tid >> 5, l = tid & 31; float sacc = P.b_ada[n0 + l];
#pragma unroll
            for (int w = 0; w < 8; ++w) sacc += red[(w * 16 + b) * 32 + l];
            mod[b * 6144 + n0 + l] = sacc; }
        __syncthreads();
        if (tid == 0) { __builtin_amdgcn_fence(__ATOMIC_RELEASE, "agent"); asm volatile("s_waitcnt vmcnt(0)" ::: "memory");
            __hip_atomic_fetch_add((unsigned*)(P.ws + WS_CTL) + CW_MOD, 1u, __ATOMIC_RELAXED, __HIP_MEMORY_SCOPE_AGENT); }
    }
}
__device__ __forceinline__ void p_prep(const Ptrs& P, unsigned char* lds, int bid, int G, const int TID) {
    const int wave = TID >> 6, lane = TID & 63;
    float* scr = (float*)lds + wave * (64 * 33);
    const int gw = bid * 8 + wave, NGW = G * 8;
    constexpr int I_IN = (D / 64) * (INW / 32), I_SQ = (D / 64) * (D / 32);
    constexpr int NIT = I_IN + 3 * I_SQ;
    bf16* WIN = (bf16*)(P.ws + WS_WIN); bf16* WAB = (bf16*)(P.ws + WS_WAB); bf16* WO = (bf16*)(P.ws + WS_WO);
    const bool split = (G == 256) && (NIT == 192 * 8 * 2 + 64 * 8 * 4);
    const int nmine = split ? (bid < 192 ? 2 : 4) : (NIT - gw + NGW - 1) / NGW;
    const int first = split ? (bid < 192 ? gw * 2 : 192 * 8 * 2 + (gw - 192 * 8) * 4) : gw, step = split ? 1 : NGW;
    for (int n_ = 0; n_ < nmine; ++n_) { const int it = first + n_ * step; if (it >= NIT) break;
        int r = it;
        if (r < I_IN) { const int nblk = INW / 32, kb = r / nblk, nb = r % nblk; const int n0 = 32 * nb;
            const int drow = n0 < 5120 ? n0 : (n0 < 6144 ? 5120 + 256 * ((n0 - 5120) >> 7) + 2 * ((n0 - 5120) & 127) : 5120 + 256 * ((n0 - 6144) >> 7) + 2 * ((n0 - 6144) & 127) + 32);
            transpose_item(P.w_in, INW, 64 * kb, n0, WIN + (size_t)drow * D + 64 * kb, D, scr, lane); continue; } r -= I_IN;
        if (r < I_SQ) { const int nblk = D / 32, kb = r / nblk, nb = r % nblk; transpose_item(P.wa, D, 64 * kb, 32 * nb, WAB + (size_t)(32 * nb) * 2048 + 64 * kb, 2048, scr, lane); continue; } r -= I_SQ;
        if (r < I_SQ) { const int nblk = D / 32, kb = r / nblk, nb = r % nblk; transpose_item(P.wb, D, 64 * kb, 32 * nb, WAB + (size_t)(32 * nb) * 2048 + 1024 + 64 * kb, 2048, scr, lane); continue; } r -= I_SQ;
        { const int nblk = D / 32, kb = r / nblk, nb = r % nblk; transpose_item(P.wo, D, 64 * kb, 32 * nb, WO + (size_t)(32 * nb) * D + 64 * kb, D, scr, lane); }
    }
    bf16* SW = (bf16*)(P.ws + WS_SW);
    for (int i = bid * 512 + TID; i < 8 * 128 * 128; i += G * 512) { const int s = i & 127, t = (i >> 7) & 127; SW[i] = (bf16)f2bf(s <= t ? P.sgu_w[i] : 0.f); }
}
constexpr int MOE_PREP_ITEMS = NE * (2 * (D / 64) * (DE / 32) + (DE / 64) * (D / 32));
constexpr int FILL_PER_WAVE = 2, FILL_PER_SEAM = 7 * FILL_PER_WAVE, FILL_SEAMS = 4;
__device__ __forceinline__ void p_prep_moe_item(const Ptrs& P, float* scr, int r, int lane) {
    if (r >= MOE_PREP_ITEMS) return;
    constexpr int I_GU = (D / 64) * (DE / 32), I_D = (DE / 64) * (D / 32);
    bf16* WGU = (bf16*)(P.ws + WS_WGU); bf16* WDn = (bf16*)(P.ws + WS_WD);
    const int per_e = 2 * I_GU + I_D; const int e = r / per_e; r -= e * per_e;
    if (r < 2 * I_GU) { const int up = r / I_GU; r -= up * I_GU; const int nblk = DE / 32, kb = r / nblk, nb = r % nblk; const int n0 = 32 * nb;
        const int drow = 256 * (n0 >> 7) + 128 * up + (n0 & 127);
        transpose_item((up ? P.wu : P.wg) + (size_t)e * D * DE, DE, 64 * kb, n0, WGU + ((size_t)e * 1024 + drow) * D + 64 * kb, D, scr, lane); return; }
    r -= 2 * I_GU;
    { const int nblk = D / 32, kb = r / nblk, nb = r % nblk; transpose_item(P.wd + (size_t)e * DE * D, D, 64 * kb, 32 * nb, WDn + ((size_t)e * 1024 + 32 * nb) * DE + 64 * kb, DE, scr, lane); }
}
__device__ __forceinline__ void p_h(const Ptrs& P, int bid, int G, const int TID) {
    const int wave = TID >> 6, lane = TID & 63;
    const float* mod = (const float*)(P.ws + WS_MOD); bf16* Hh = (bf16*)P.out;
    if (wave == 0) { const unsigned* pc = (const unsigned*)(P.ws + WS_CTL) + CW_MOD; unsigned polls = 0;
        while ((unsigned)__builtin_amdgcn_readfirstlane(__hip_atomic_load(pc, __ATOMIC_RELAXED, __HIP_MEMORY_SCOPE_AGENT)) < 6144u / 32u) { if (++polls > (1u << 22)) break; __builtin_amdgcn_s_sleep(2); }
        __builtin_amdgcn_fence(__ATOMIC_ACQUIRE, "agent"); asm volatile("s_waitcnt vmcnt(0)" ::: "memory"); }
    __syncthreads();
    for (int blk = bid; blk < T / 128; blk += G) {
        const int b = (blk * 128) >> 11; const float* shift = mod + b * 6144; const float* scale = shift + 1024;
        f32x4 cm[4], ca[4];
#pragma unroll
        for (int j = 0; j < 4; ++j) { const int col = (64 * j + lane) * 4; cm[j] = *(const f32x4*)(P.g1 + col) * (*(const f32x4*)(scale + col) + 1.0f); ca[j] = *(const f32x4*)(shift + col); }
        const int row0 = blk * 128 + wave * 16;
        f32x4 nx[4];
#pragma unroll
        for (int j = 0; j < 4; ++j) nx[j] = ((const f32x4*)(P.x + (size_t)row0 * D) + lane)[64 * j];
        for (int rr = 0; rr < 16; ++rr) { const int row = row0 + rr;
            f32x4 v[4]; float ss = 0.f;
#pragma unroll
            for (int j = 0; j < 4; ++j) { v[j] = nx[j]; ss += (v[j].x * v[j].x + v[j].y * v[j].y) + (v[j].z * v[j].z + v[j].w * v[j].w); }
            if (rr + 1 < 16) {
#pragma unroll
                for (int j = 0; j < 4; ++j) nx[j] = ((const f32x4*)(P.x + (size_t)(row + 1) * D) + lane)[64 * j]; }
            const float rs = 1.0f / sqrtf(wave_sum_dpp(ss) * (1.0f / D) + EPS);
#pragma unroll
            for (int j = 0; j < 4; ++j) { const int col = (64 * j + lane) * 4;
                const f32x4 o = v[j] * rs * cm[j] + ca[j];
                u32x2 w; w.x = pk2(o.x, o.y); w.y = pk2(o.z, o.w);
                *(u32x2*)(Hh + (size_t)row * D + col) = w; }
        }
    }
}
__device__ __forceinline__ void p_qknorm_vstat(const Ptrs& P, int bid, int G, const int TID) {
    const int wave = TID >> 6, lane = TID & 63;
    bf16* Q = (bf16*)(P.ws + WS_Q); bf16* Kb = (bf16*)(P.ws + WS_K); const bf16* GV = (const bf16*)(P.ws + WS_GV); float* vstat = (float*)(P.ws + WS_VSTAT);
    for (int it = bid * 8 + wave; it < 2 * T; it += G * 8) {
        const int row = it >> 1, isk = it & 1; bf16* p = (isk ? Kb : Q) + (size_t)row * D + lane * 16; const float* g = (isk ? P.kg : P.qg) + (lane & 7) * 16;
        u32x4 w0 = *(u32x4*)p, w1 = *(u32x4*)(p + 8);
        float v[16] = {bflo(w0.x), bfhi(w0.x), bflo(w0.y), bfhi(w0.y), bflo(w0.z), bfhi(w0.z), bflo(w0.w), bfhi(w0.w), bflo(w1.x), bfhi(w1.x), bflo(w1.y), bfhi(w1.y), bflo(w1.z), bfhi(w1.z), bflo(w1.w), bfhi(w1.w)};
        float ss = 0.f;
#pragma unroll
        for (int i = 0; i < 16; ++i) ss += v[i] * v[i];
        ss += __shfl_xor(ss, 1); ss += __shfl_xor(ss, 2); ss += __shfl_xor(ss, 4);
        const float rs = (1.0f / sqrtf(ss * (1.0f / DH) + EPS)) * (isk ? 1.0f : QSCALE);
#pragma unroll
        for (int i = 0; i < 16; ++i) v[i] = v[i] * rs * g[i];
        w0.x = pk2(v[0], v[1]); w0.y = pk2(v[2], v[3]); w0.z = pk2(v[4], v[5]); w0.w = pk2(v[6], v[7]);
        w1.x = pk2(v[8], v[9]); w1.y = pk2(v[10], v[11]); w1.z = pk2(v[12], v[13]); w1.w = pk2(v[14], v[15]);
        *(u32x4*)p = w0; *(u32x4*)(p + 8) = w1;
    }
    for (int row = bid * 8 + wave; row < T; row += G * 8) {
        const bf16* p = GV + (size_t)row * D + lane * 16;
        const u32x4 w0 = *(const u32x4*)p, w1 = *(const u32x4*)(p + 8);
        const unsigned ww[8] = {w0.x, w0.y, w0.z, w0.w, w1.x, w1.y, w1.z, w1.w};
        float ss = 0.f;
#pragma unroll
        for (int i = 0; i < 8; ++i) { const float a = bflo(ww[i]), b = bfhi(ww[i]); ss += a * a + b * b; }
        ss = wave_sum(ss);
        if (lane == 0) vstat[row] = 1.0f / sqrtf(ss * (1.0f / D) + EPS);
    }
}
__device__ __forceinline__ void p_route(const Ptrs& P, unsigned char* lds, int bid, int G, const int TID) {
    float* Wr = (float*)lds;
    int* lcnt = (int*)(Wr + 20 * 1024);
    int* gbase = lcnt + 32;
    int* dec_c = gbase + 32;
    int* dec_lp = dec_c + 128;
    float* dec_w = (float*)(dec_lp + 128);
    const int tid = TID, wave = tid >> 6, lane = tid & 63;
    const float* mod = (const float*)(P.ws + WS_MOD); bf16* H2 = (bf16*)(P.ws + WS_H2);
    int* TOK = (int*)(P.ws + WS_TOK); float* WW = (float*)(P.ws + WS_WW);
    unsigned* cnt = (unsigned*)(P.ws + WS_CTL) + CTL_CNT;
    for (int i = tid; i < 20 * 1024; i += 512) { const int j = i >> 10, k = i & 1023; Wr[i] = (j < 4) ? P.w_rg[k * 4 + j] : P.w_re[(size_t)((j - 4) >> 2) * 4096 + k * 4 + ((j - 4) & 3)]; }
    for (int blk = bid; blk < T / 128; blk += G) {
        if (tid < 32) lcnt[tid] = 0;
        if (wave == 0) { const unsigned* pc = (const unsigned*)(P.ws + WS_CTL) + CW_PAN_X1 + 64 * (blk >> 1); unsigned polls = 0;
            while ((unsigned)__builtin_amdgcn_readfirstlane(__hip_atomic_load(pc, __ATOMIC_RELAXED, __HIP_MEMORY_SCOPE_AGENT)) < 32u) { if (++polls > (1u << 20)) break; __builtin_amdgcn_s_sleep(2); }
            __builtin_amdgcn_fence(__ATOMIC_ACQUIRE, "agent"); asm volatile("s_waitcnt vmcnt(0)" ::: "memory"); }
        __syncthreads();
        const int b = (blk * 128) >> 11;
        const float* shift = mod + b * 6144 + 3072; const float* scale = shift + 1024;
        f32x4 cm[4], ca[4];
#pragma unroll
        for (int j = 0; j < 4; ++j) { const int col = (64 * j + lane) * 4; cm[j] = *(const f32x4*)(P.g2 + col) * (*(const f32x4*)(scale + col) + 1.0f); ca[j] = *(const f32x4*)(shift + col); }
        f32x4 wg[4][4];
#pragma unroll
        for (int j = 0; j < 4; ++j)
#pragma unroll
            for (int q = 0; q < 4; ++q) wg[j][q] = *(const f32x4*)(Wr + q * 1024 + (64 * j + lane) * 4);
        u32x2 nx[2][4];
#pragma unroll
        for (int u = 0; u < 2; ++u) { const u32x2* xr = (const u32x2*)(P.ws + WS_X1 + (size_t)(blk * 128 + wave * 16 + u) * (D * 2)) + lane;
#pragma unroll
            for (int j = 0; j < 4; ++j) nx[u][j] = xr[64 * j]; }
        for (int rr = 0; rr < 16; rr += 2) {
            f32x4 o[2][4]; float ssq[2];
#pragma unroll
            for (int u = 0; u < 2; ++u) { float ss = 0.f;
#pragma unroll
                for (int j = 0; j < 4; ++j) { const u32x2 xw = nx[u][j]; o[u][j] = (f32x4){bflo(xw.x), bfhi(xw.x), bflo(xw.y), bfhi(xw.y)}; ss += (o[u][j].x * o[u][j].x + o[u][j].y * o[u][j].y) + (o[u][j].z * o[u][j].z + o[u][j].w * o[u][j].w); }
                ssq[u] = ss; }
            if (rr + 2 < 16) {
#pragma unroll
                for (int u = 0; u < 2; ++u) { const u32x2* xr = (const u32x2*)(P.ws + WS_X1 + (size_t)(blk * 128 + wave * 16 + rr + 2 + u) * (D * 2)) + lane;
#pragma unroll
                    for (int j = 0; j < 4; ++j) nx[u][j] = xr[64 * j]; } }
            ssq[0] = wave_sum_dpp(ssq[0]); ssq[1] = wave_sum_dpp(ssq[1]);
            f32x4 gp[2];
#pragma unroll
            for (int u = 0; u < 2; ++u) { const int row = blk * 128 + wave * 16 + rr + u; const float rs = 1.0f / sqrtf(ssq[u] * (1.0f / D) + EPS);
                gp[u] = (f32x4){0.f, 0.f, 0.f, 0.f};
#pragma unroll
                for (int j = 0; j < 4; ++j) { const int col = (64 * j + lane) * 4;
                    o[u][j] = o[u][j] * rs * cm[j] + ca[j];
                    u32x2 w; w.x = pk2(o[u][j].x, o[u][j].y); w.y = pk2(o[u][j].z, o[u][j].w);
                    *(u32x2*)(H2 + (size_t)row * D + col) = w;
#pragma unroll
                    for (int q = 0; q < 4; ++q) { const f32x4 wr = wg[j][q]; gp[u][q] += (o[u][j].x * wr.x + o[u][j].y * wr.y) + (o[u][j].z * wr.z + o[u][j].w * wr.w); } } }
#pragma unroll
            for (int q = 0; q < 4; ++q) { gp[0][q] = wave_sum_dpp(gp[0][q]); gp[1][q] = wave_sum_dpp(gp[1][q]); }
            int gtv[2]; float pgv[2]; f32x4 ep[2];
#pragma unroll
            for (int u = 0; u < 2; ++u) { float gl[4];
#pragma unroll
                for (int j = 0; j < 4; ++j) gl[j] = gp[u][j] + P.b_rg[j];
                int gt = 0; float gm = gl[0];
#pragma unroll
                for (int j = 1; j < 4; ++j) if (gl[j] > gm) { gm = gl[j]; gt = j; }
                float den = 0.f;
#pragma unroll
                for (int j = 0; j < 4; ++j) den += __expf(gl[j] - gm);
                gtv[u] = gt; pgv[u] = 1.0f / den;
                ep[u] = (f32x4){0.f, 0.f, 0.f, 0.f};
                const float* We = Wr + (4 + gt * 4) * 1024;
#pragma unroll
                for (int j = 0; j < 4; ++j) { const int col = (64 * j + lane) * 4;
#pragma unroll
                    for (int q = 0; q < 4; ++q) { const f32x4 wr = *(const f32x4*)(We + q * 1024 + col); ep[u][q] += (o[u][j].x * wr.x + o[u][j].y * wr.y) + (o[u][j].z * wr.z + o[u][j].w * wr.w); } } }
#pragma unroll
            for (int q = 0; q < 4; ++q) { ep[0][q] = wave_sum_dpp(ep[0][q]); ep[1][q] = wave_sum_dpp(ep[1][q]); }
#pragma unroll
            for (int u = 0; u < 2; ++u) { const int lrow = wave * 16 + rr + u; const int gt = gtv[u]; float el[4];
#pragma unroll
                for (int e = 0; e < 4; ++e) el[e] = ep[u][e] + P.b_re[gt * 4 + e];
                int i0 = 0; float v0 = el[0];
#pragma unroll
                for (int e = 1; e < 4; ++e) if (el[e] > v0) { v0 = el[e]; i0 = e; }
                int i1 = -1; float v1 = -3.0e38f;
#pragma unroll
                for (int e = 0; e < 4; ++e) if (e != i0 && el[e] > v1) { v1 = el[e]; i1 = e; }
                const float e1 = __expf(v1 - v0); const float p0 = pgv[u] / (1.0f + e1), p1 = pgv[u] * e1 / (1.0f + e1);
                if (lane == 0) { const int ea = i0 < i1 ? i0 : i1, eb = i0 < i1 ? i1 : i0; const int pi = ea == 0 ? eb - 1 : (ea == 1 ? eb + 1 : 5); const int cl = gt * 6 + pi;
                    dec_c[lrow] = cl; dec_w[lrow * 2] = i0 < i1 ? p0 : p1; dec_w[lrow * 2 + 1] = i0 < i1 ? p1 : p0;
                    dec_lp[lrow] = atomicAdd(&lcnt[cl], 1); } }
        }
        __syncthreads();
        int t2 = tid; OPAQUE(t2);
        if (t2 < NCLS) gbase[t2] = (int)atomicAdd(&cnt[t2], (unsigned)lcnt[t2]);
        __syncthreads();
        if (t2 < 128) { const int cl = dec_c[t2], pos = gbase[cl] + dec_lp[t2]; const int tok = blk * 128 + t2;
            TOK[(size_t)cl * T + pos] = tok; WW[((size_t)cl * T + pos) * 2] = dec_w[t2 * 2]; WW[((size_t)cl * T + pos) * 2 + 1] = dec_w[t2 * 2 + 1]; }
        __syncthreads();
    }
}
struct Args { Ptrs p; int ph_lo, ph_hi; };
constexpr int N_PHASES = 9;
__global__ void __launch_bounds__(512, 2) mk_fwd(Args args) {
    extern __shared__ __attribute__((aligned(16))) unsigned char lds[];
    const Ptrs& P = args.p;
    LAS unsigned char* L = (LAS unsigned char*)lds;
    volatile LAS unsigned* MISC = (volatile LAS unsigned*)(L + LDS_MISC);
    LAS int* tb = (LAS int*)(L + LDS_MISC + 256);
    const int wid_s = __builtin_amdgcn_readfirstlane((int)threadIdx.x >> 6);
#define TIDX() ((wid_s << 6) | lane_id_fresh())
    const int G = gridDim.x, bid = blockIdx.x;
    const int vcu = (G % 8 == 0) ? (bid % 8) * (G / 8) + bid / 8 : bid;
    unsigned char* ws = P.ws;
    for (int u = TIDX(); u < (LDS_BYTES - LDS_MISC) / 4; u += 512) ((LAS unsigned*)(L + LDS_MISC))[u] = 0u;
    __syncthreads();
    XcdBarrier bar = xcd_barrier_post((unsigned*)(ws + WS_CTL) + CW_BAR, MISC + 8, wid_s == 0);
    const int lo = args.ph_lo, hi = args.ph_hi;
#define IN(k) (lo <= (k) && (k) < hi)
#define SEAM(k) do { if (IN(k) && IN((k) + 1)) xcd_barrier(bar, NoFill{}); } while (0)
#define SEAMF(k) do { if (IN(k) && IN((k) + 1)) xcd_barrier(bar, [&]() { \
        const int npw_ = (k) == 1 ? 3 : 2, base_ = (k) == 1 ? 0 : 21 + ((k) - 2) * 14;     \
        _Pragma("unroll 1") for (int k_ = 0; k_ < npw_; ++k_) { const int slot_ = base_ + (wid_s - 1) * npw_ + k_; \
            p_prep_moe_item(P, (float*)lds + wid_s * (64 * 33), slot_ * G + vcu, lane_id_fresh()); } }); } while (0)
    bf16* Hh = (bf16*)P.out; bf16* GU = (bf16*)((unsigned char*)P.out + 64 * MiB); bf16* SG = Hh;
    bf16* GV = (bf16*)(ws + WS_GV); bf16* Q = (bf16*)(ws + WS_Q); bf16* Kb = (bf16*)(ws + WS_K); bf16* V = (bf16*)(ws + WS_V); bf16* SA = (bf16*)(ws + WS_SA); bf16* SB = (bf16*)(ws + WS_SB);
    bf16* MG = (bf16*)(ws + WS_MG); bf16* H2 = (bf16*)(ws + WS_H2); bf16* ACT = (bf16*)(ws + WS_ACT);
    const float* mod = (const float*)(ws + WS_MOD); const unsigned* cnt = (const unsigned*)(ws + WS_CTL) + CTL_CNT; unsigned* ctlw = (unsigned*)(ws + WS_CTL);

    if (IN(0)) { p_mod(P, lds, bid, G, TIDX()); __syncthreads(); p_prep(P, lds, bid, G, TIDX());
        if (hi - lo < N_PHASES) { for (int sl = wid_s; sl * G + vcu < MOE_PREP_ITEMS; sl += 8) p_prep_moe_item(P, (float*)lds + wid_s * (64 * 33), sl * G + vcu, lane_id_fresh()); } }
    if (IN(1)) { p_h(P, bid, G, TIDX()); } SEAMF(1);
    if (IN(2)) {
        pg8::DenseOrder S{(const char*)Hh, (const char*)Hh, (const char*)(ws + WS_WIN), (size_t)256 * D * 2, (size_t)256 * D * 2, T / 256, INW / 256, (T / 256) * (INW / 256), G, bid, nullptr, 0u, nullptr, nullptr};
        EpiInProj E{GU, GV, Q, Kb, V, SA, SB, P.qg, P.kg, (float*)(ws + WS_VSTAT), (LAS float*)(L + LDS_EPI)};
        pg8::gemm_phase<EpiInProj, pg8::DenseOrder, false, false>(L + LDS_STAGE, D / 64, D / 64, D, D, S, E, TIDX());
    } SEAMF(2);
    if (IN(3)) { sgu::sgu_phase(GU, GV, (const float*)(ws + WS_VSTAT), P.sgn, (const bf16*)(ws + WS_SW), P.sgu_b, SG, lds, vcu, G, TIDX()); att::attn_phase(Kb, V, Q, P.qg, P.kg, lds, vcu, G, TIDX()); } SEAMF(3);
    if (IN(3) && IN(4)) { for (int sl = 49 + wid_s; sl * G + vcu < MOE_PREP_ITEMS; sl += 8) p_prep_moe_item(P, (float*)lds + wid_s * (64 * 33), sl * G + vcu, lane_id_fresh()); __syncthreads(); }
    if (IN(4)) {
        pg8::DenseOrder S{(const char*)SG, (const char*)Q - (size_t)16 * 128, (const char*)(ws + WS_WAB), (size_t)256 * D * 2, (size_t)256 * 2048 * 2, T / 256, 4, (T / 256) * 4, G, bid, nullptr, 0u, ctlw + CW_PAN_MG, nullptr};
        EpiProjAB E{SA, SB, MG};
        pg8::gemm_phase<EpiProjAB, pg8::DenseOrder, false, true>(L + LDS_STAGE, 32, 16, D, 2048, S, E, TIDX());
    }
    if (IN(5)) {
        pg8::DenseOrder S{(const char*)MG, (const char*)MG, (const char*)(ws + WS_WO), (size_t)256 * D * 2, (size_t)256 * D * 2, T / 256, 4, (T / 256) * 4, G, bid, ctlw + CW_PAN_MG, 32u, ctlw + CW_PAN_X1, ctlw + CW_BAR + XB_TMO};
        EpiOut E{P.x, mod, (bf16*)(ws + WS_X1)};
        pg8::gemm_phase<EpiOut, pg8::DenseOrder, false, false>(L + LDS_STAGE, D / 64, D / 64, D, D, S, E, TIDX());
    }
    if (IN(6)) { p_route(P, lds, bid, G, TIDX()); } SEAM(6);
    if (IN(7) || IN(8)) {
        if (TIDX() == 0) { int base = 0; for (int c = 0; c < NCLS; ++c) { tb[c] = base; base += ((int)cnt[c] + 255) >> 8; } tb[NCLS] = base; }
        __syncthreads();
    }
    if (IN(7)) {
        pg8::MoeOrder1 S{tb, cnt, (const char*)H2, (const char*)(ws + WS_WGU), (const int*)(ws + WS_TOK), G, vcu, (unsigned*)(ws + WS_CTL) + CW_TILE};
        EpiMoe1 E{ACT, (const float*)(ws + WS_WW)};
        pg8::gemm_phase<EpiMoe1, pg8::MoeOrder1, true, false>(L + LDS_STAGE, D / 64, D / 64, D, D, S, E, TIDX());
    }
    if (IN(8)) {
        pg8::MoeOrder2 S{tb, cnt, (const char*)ACT, (const char*)(ws + WS_WD), (const int*)(ws + WS_TOK), G, G - 1 - vcu  , (unsigned*)(ws + WS_CTL) + CW_TILE, (unsigned*)(ws + WS_CTL) + CW_BAR + XB_TMO};
        EpiMoe2 E{P.out, mod, (const bf16*)(ws + WS_X1)};
        pg8::gemm_phase<EpiMoe2, pg8::MoeOrder2, false, false, true>(L + LDS_STAGE, 16, 8, 1024, DE, S, E, TIDX());
    }
#undef IN
#undef SEAM
#undef SEAMF
}

#ifndef MK_PER_PHASE
#define MK_PER_PHASE 0
#endif
extern "C" void kernel_launch(void* const* d_in, const int* in_sizes, int n_in, void* d_out, int out_size, void* d_ws, size_t ws_size, hipStream_t stream) {
    static int grid = 0;
    if (grid == 0) {
        if (n_in != 22 || in_sizes[0] != T * D || out_size != T * D || ws_size < WS_END) { fprintf(stderr, "kernel_launch: shape/ws mismatch n_in %d in0 %d out %d ws %zu\n", n_in, n_in > 0 ? in_sizes[0] : -1, out_size, ws_size); grid = -1; return; }
        int dev = 0, cus = 0;
        if (hipGetDevice(&dev) != hipSuccess || hipDeviceGetAttribute(&cus, hipDeviceAttributeMultiprocessorCount, dev) != hipSuccess) { grid = -1; return; }
        if (hipFuncSetAttribute((const void*)mk_fwd, hipFuncAttributeMaxDynamicSharedMemorySize, LDS_BYTES) != hipSuccess) { fprintf(stderr, "kernel_launch: hipFuncSetAttribute failed\n"); grid = -1; return; }
        grid = cus;
    }
    if (grid < 0) return;
    (void)hipMemsetAsync((char*)d_ws + WS_CTL, 0, 1 * MiB, stream);
    Args a{};
    const float** pp = (const float**)&a.p;
    for (int i = 0; i < 22; ++i) pp[i] = (const float*)d_in[i];
    a.p.out = (float*)d_out; a.p.ws = (unsigned char*)d_ws;
#if MK_PER_PHASE
    for (int k = 0; k < N_PHASES; ++k) { a.ph_lo = k; a.ph_hi = k + 1; hipLaunchKernelGGL(mk_fwd, dim3(grid), dim3(512), LDS_BYTES, stream, a); }
#else
    a.ph_lo = 0; a.ph_hi = N_PHASES;
    hipLaunchKernelGGL(mk_fwd, dim3(grid), dim3(512), LDS_BYTES, stream, a);
#endif
}
```

```cpp
#include <hip/hip_runtime.h>
#include <cstdio>
#include <cstdint>

#define LAS __attribute__((address_space(3)))
typedef unsigned short bf16;
typedef float f32x4 __attribute__((ext_vector_type(4)));
typedef unsigned u32x4 __attribute__((ext_vector_type(4)));
typedef unsigned u32x2 __attribute__((ext_vector_type(2)));
typedef short bf16x8 __attribute__((ext_vector_type(8)));

constexpr int NB = 16, S = 2048, D = 1024, T = NB * S, INW = 7168, NH = 8, DH = 128, NE = 16, DE = 512, NCLS = 24;
constexpr float EPS = 1e-6f;
constexpr float LOG2E = 1.4426950408889634f;
constexpr float QSCALE = 0.08838834764831845f * LOG2E;

constexpr size_t MiB = 1u << 20;
constexpr size_t WS_CTL = 0;
constexpr size_t WS_WIN = 2 * MiB;
constexpr size_t WS_WAB = 16 * MiB;
constexpr size_t WS_WO = 20 * MiB;
constexpr size_t WS_WGU = 22 * MiB;
constexpr size_t WS_WD = 54 * MiB;
constexpr size_t WS_MOD = 70 * MiB;
constexpr size_t WS_VSTAT = 71 * MiB;
constexpr size_t WS_SW = 71 * MiB + 512 * 1024;
constexpr size_t WS_TOK = 72 * MiB;
constexpr size_t WS_WW = 464 * MiB;
constexpr size_t WS_GV = 80 * MiB;
constexpr size_t WS_Q = 144 * MiB;
constexpr size_t WS_K = 208 * MiB;
constexpr size_t WS_V = 272 * MiB;
constexpr size_t WS_SA = 336 * MiB;
constexpr size_t WS_SB = 400 * MiB;
constexpr size_t WS_END = 512 * MiB;
constexpr size_t WS_ACT = 336 * MiB;
constexpr size_t WS_MG = WS_K, WS_H2 = WS_Q;
constexpr size_t WS_X1 = WS_GV;
constexpr int CTL_CNT = 1024;
constexpr int CW_BAR = 4096;
constexpr int CW_PAN_MG = 32768, CW_PAN_X1 = 49152;
constexpr int CW_TILE = 16384;

constexpr int LDS_STAGE = 0;
constexpr int LDS_EPI = 131072;
constexpr int LDS_MISC = 139264;
constexpr int LDS_BYTES = 147456;

__device__ __forceinline__ unsigned f2bf(float f) { unsigned u = __builtin_bit_cast(unsigned, f); return (u + 0x7fffu + ((u >> 16) & 1u)) >> 16; }
__device__ __forceinline__ unsigned pk2(float lo, float hi) { return f2bf(lo) | (f2bf(hi) << 16); }
__device__ __forceinline__ float bf2f(unsigned short b) { return __builtin_bit_cast(float, ((unsigned)b) << 16); }
__device__ __forceinline__ float bflo(unsigned w) { return __builtin_bit_cast(float, w << 16); }
__device__ __forceinline__ float bfhi(unsigned w) { return __builtin_bit_cast(float, w & 0xffff0000u); }
__device__ __forceinline__ unsigned cvt_pk_bf16(float lo, float hi) { unsigned r; asm volatile("v_cvt_pk_bf16_f32 %0, %1, %2" : "=v"(r) : "v"(lo), "v"(hi)); return r; }
__device__ __forceinline__ float wave_sum(float v) {
#pragma unroll
    for (int o = 1; o < 64; o <<= 1) v += __shfl_xor(v, o);
    return v;
}
__device__ __forceinline__ float row16_sum(float x) {
    x += __builtin_bit_cast(float, __builtin_amdgcn_update_dpp(0, __builtin_bit_cast(int, x), 0xB1, 0xF, 0xF, true));
    x += __builtin_bit_cast(float, __builtin_amdgcn_update_dpp(0, __builtin_bit_cast(int, x), 0x4E, 0xF, 0xF, true));
    x += __builtin_bit_cast(float, __builtin_amdgcn_update_dpp(0, __builtin_bit_cast(int, x), 0x141, 0xF, 0xF, true));
    x += __builtin_bit_cast(float, __builtin_amdgcn_update_dpp(0, __builtin_bit_cast(int, x), 0x140, 0xF, 0xF, true));
    return x;
}
__device__ __forceinline__ float rows_sum(float x) {
    { unsigned a = __builtin_bit_cast(unsigned, x), b = a; asm volatile("" : "+v"(b));
      const auto r = __builtin_amdgcn_permlane16_swap(a, b, false, false); x = __builtin_bit_cast(float, (unsigned)r[0]) + __builtin_bit_cast(float, (unsigned)r[1]); }
    { unsigned a = __builtin_bit_cast(unsigned, x), b = a; asm volatile("" : "+v"(b));
      const auto r = __builtin_amdgcn_permlane32_swap(a, b, false, false); x = __builtin_bit_cast(float, (unsigned)r[0]) + __builtin_bit_cast(float, (unsigned)r[1]); }
    return x;
}
__device__ __forceinline__ float wave_sum_dpp(float x) {
    x = row16_sum(x);
    { unsigned a = __builtin_bit_cast(unsigned, x), b = a; asm volatile("" : "+v"(b));
      const auto r = __builtin_amdgcn_permlane16_swap(a, b, false, false); x = __builtin_bit_cast(float, (unsigned)r[0]) + __builtin_bit_cast(float, (unsigned)r[1]); }
    { unsigned a = __builtin_bit_cast(unsigned, x), b = a; asm volatile("" : "+v"(b));
      const auto r = __builtin_amdgcn_permlane32_swap(a, b, false, false); x = __builtin_bit_cast(float, (unsigned)r[0]) + __builtin_bit_cast(float, (unsigned)r[1]); }
    return x;
}
__device__ __forceinline__ void st16_wt(void* base, unsigned byte_off, u32x4 v) {
    const __amdgpu_buffer_rsrc_t r = __builtin_amdgcn_make_buffer_rsrc(base, 0, 0x7fffffff, 0x00020000);
    __builtin_amdgcn_raw_buffer_store_b128(v, r, (int)byte_off, 0, 16);
}
__device__ __forceinline__ int lane_id_fresh() { int l; asm volatile("v_mbcnt_lo_u32_b32 %0, -1, 0\n\tv_mbcnt_hi_u32_b32 %0, -1, %0" : "=v"(l)); return l; }
__device__ __forceinline__ float fast_rcp(float x) { return __builtin_amdgcn_rcpf(x); }
__device__ __forceinline__ float gelu_tanh(float x) {
    const float u = x * (0.7978845608028654f + 0.035677408136300125f * x * x);
    return x * fast_rcp(1.0f + __builtin_amdgcn_exp2f(-2.0f * LOG2E * u));
}
__device__ __forceinline__ float sigmoidf_(float x) { return fast_rcp(1.0f + __builtin_amdgcn_exp2f(-LOG2E * x)); }
__device__ __forceinline__ f32x4 exp2_4(f32x4 t) { f32x4 e; e.x = __builtin_amdgcn_exp2f(t.x); e.y = __builtin_amdgcn_exp2f(t.y); e.z = __builtin_amdgcn_exp2f(t.z); e.w = __builtin_amdgcn_exp2f(t.w); return e; }
__device__ __forceinline__ f32x4 rcp_4(f32x4 t) { f32x4 e; e.x = fast_rcp(t.x); e.y = fast_rcp(t.y); e.z = fast_rcp(t.z); e.w = fast_rcp(t.w); return e; }
__device__ __forceinline__ f32x4 gelu4(f32x4 x) {
    const f32x4 t = x * (x * x * (-2.0f * LOG2E * 0.035677408136300125f) + (-2.0f * LOG2E * 0.7978845608028654f));
    return x * rcp_4(exp2_4(t) + 1.0f);
}
__device__ __forceinline__ f32x4 sigmoid4(f32x4 x) { return rcp_4(exp2_4(x * (-LOG2E)) + 1.0f); }
__device__ __forceinline__ float siluf_(float x) { return x * fast_rcp(1.0f + __builtin_amdgcn_exp2f(-LOG2E * x)); }

__device__ __forceinline__ unsigned dpp_swap1(unsigned x) { return (unsigned)__builtin_amdgcn_update_dpp(0, (int)x, 0xB1, 0xF, 0xF, false); }
template <bool NT> __device__ __forceinline__ void st_lines(char* p, unsigned ld, u32x4 w0, u32x4 w1, bool odd) {
    const u32x4 x = odd ? w0 : w1; u32x4 y; y.x = dpp_swap1(x.x); y.y = dpp_swap1(x.y); y.z = dpp_swap1(x.z); y.w = dpp_swap1(x.w);
    const u32x4 d1 = odd ? y : w0, d2 = odd ? w1 : y;
    if constexpr (NT) { __builtin_nontemporal_store(d1, (u32x4*)p); __builtin_nontemporal_store(d2, (u32x4*)(p + ld)); }
    else { *(u32x4*)p = d1; *(u32x4*)(p + ld) = d2; }
}
__device__ __forceinline__ void st_lines_wt(void* base, unsigned off, unsigned ld, u32x4 w0, u32x4 w1, bool odd) {
    const u32x4 x = odd ? w0 : w1; u32x4 y; y.x = dpp_swap1(x.x); y.y = dpp_swap1(x.y); y.z = dpp_swap1(x.z); y.w = dpp_swap1(x.w);
    st16_wt(base, off, odd ? y : w0); st16_wt(base, off + ld, odd ? w1 : y);
}
__device__ __forceinline__ void ld_lines_fix(u32x4 l1, u32x4 l2, bool odd, u32x4& w0, u32x4& w1) {
    const u32x4 x = odd ? l1 : l2; u32x4 y; y.x = dpp_swap1(x.x); y.y = dpp_swap1(x.y); y.z = dpp_swap1(x.z); y.w = dpp_swap1(x.w);
    w0 = odd ? y : l1; w1 = odd ? l2 : y;
}
namespace pg8 {
constexpr int BM = 256, BK = 64, HALF = 128, HTB = HALF * BK * 2, STAGE_BYTES = 8 * HTB, NXCD = 8, WGM = 4;
__host__ __device__ __forceinline__ int lds_byte(int r, int c) { const int st = (r >> 4) * 2 + (c >> 5), rr = r & 15, cc = c & 31, ob = rr * 64 + cc * 2; return st * 1024 + (ob ^ (((ob >> 9) & 1) << 5)); }
__host__ __device__ __forceinline__ void stage_rc(int b, int& R, int& C) { const int st = b / 1024, sb = b % 1024, swz = sb ^ (((sb >> 9) & 1) << 5); R = (st >> 1) * 16 + swz / 64; C = (st & 1) * 32 + (swz % 64) / 2; }
__host__ __device__ __forceinline__ int perm32(int rho) { const int n = rho >> 4, i = rho & 15; return 8 * (i >> 2) + 4 * n + (i & 3); }

struct Unit { const char* a; const char* a2; const char* b; const char* b2; const int* ridx; int nrows; int pm, pn, e, lt; };

template <class Epi, class Sched, bool GATHER, bool MIDK, bool BSPLIT = false>
__device__ __forceinline__ void gemm_phase(LAS unsigned char* lds, const int nt, const int ksplit, const int lda, const int ldb, const Sched& S, const Epi& E, const int TID) {
    const int tid = TID, wid = __builtin_amdgcn_readfirstlane(tid >> 6), lane = tid & 63, wr = wid >> 2, wc = wid & 3, fr = lane & 15, fq = lane >> 4;
    int RA[2], CA[2]; unsigned voffB[2];
#pragma unroll
    for (int i = 0; i < 2; ++i) { int R, C; stage_rc(tid * 16 + i * 8192, R, C); RA[i] = R; CA[i] = C; const int Rb = Epi::PERM == 2 ? (64 * (R >> 5) + perm32(R & 31)) : Epi::PERM == 1 ? ((R & ~31) + perm32(R & 31)) : R; voffB[i] = (unsigned)(Rb * ldb + C) * 2u; }
    unsigned cG[2][2], nG[2][2];
    const size_t kstep = (size_t)(BK * 2);
    const size_t hstepB = (size_t)(Epi::PERM == 2 ? 32 : HALF) * ldb * 2;
    const unsigned ldsw = (unsigned)wid * 1024u;
    const int aoff = lds_byte(wr * 64 + fr, fq * 8), boff = lds_byte(wc * 32 + fr, fq * 8);
#define PG8_SETOFF(G, u) do { _Pragma("unroll") for (int _h = 0; _h < 2; ++_h) _Pragma("unroll") for (int _i = 0; _i < 2; ++_i) { \
        int _row = _h * HALF + RA[_i]; if constexpr (GATHER) { _row = (_row < (u).nrows) ? (u).ridx[_row] : 0; } \
        G[_h][_i] = (unsigned)(_row * lda + CA[_i]) * 2u; } } while (0)
#define PG8_AP(u, t) (((MIDK && (t) >= ksplit) ? (u).a2 : (u).a) + (size_t)(t) * kstep)
#define PG8_BP(u, t) (((BSPLIT && (t) >= ksplit) ? (u).b2 : (u).b) + (size_t)(t) * kstep)
#define PG8_SA(b, h) (((b) * 2 + (h)) * HTB)
#define PG8_SB(b, h) ((4 + (b) * 2 + (h)) * HTB)
#define PG8_ST2(bufoff, p0, p1) do { __builtin_amdgcn_global_load_lds((const unsigned*)(p0), (LAS unsigned*)(lds + (bufoff) + ldsw), 16, 0, 0); \
        __builtin_amdgcn_global_load_lds((const unsigned*)(p1), (LAS unsigned*)(lds + (bufoff) + ldsw + 8192), 16, 0, 0); } while (0)
#define PG8_STAGE_B(bufoff, gb) PG8_ST2(bufoff, (gb) + voffB[0], (gb) + voffB[1])
#define PG8_STAGE_AC(bufoff, ga, h) PG8_ST2(bufoff, (ga) + cG[h][0], (ga) + cG[h][1])
#define PG8_STAGE_AS(bufoff, ga, h) PG8_ST2(bufoff, (ga) + (last ? nG[h][0] : cG[h][0]), (ga) + (last ? nG[h][1] : cG[h][1]))
#define PG8_LDA(dst, b, h) do { _Pragma("unroll") for (int m = 0; m < 4; ++m) _Pragma("unroll") for (int k = 0; k < 2; ++k) dst[m][k] = *(const LAS bf16x8*)(lds + PG8_SA(b, h) + aoff + m * 2048 + k * 1024); } while (0)
#define PG8_LDB(dst, b, h) do { _Pragma("unroll") for (int n = 0; n < 2; ++n) _Pragma("unroll") for (int k = 0; k < 2; ++k) dst[n][k] = *(const LAS bf16x8*)(lds + PG8_SB(b, h) + boff + n * 2048 + k * 1024); } while (0)
#define PG8_MMA(ai, bj, At, Bt) do { __builtin_amdgcn_s_setprio(1); _Pragma("unroll") for (int m = 0; m < 4; ++m) _Pragma("unroll") for (int n = 0; n < 2; ++n) _Pragma("unroll") for (int k = 0; k < 2; ++k) \
        acc[ai][bj][m][n] = __builtin_amdgcn_mfma_f32_16x16x32_bf16(Bt[n][k], At[m][k], acc[ai][bj][m][n], 0, 0, 0); __builtin_amdgcn_s_setprio(0); } while (0)
#define PG8_WAIT_V(n) asm volatile("s_waitcnt vmcnt(" #n ")" ::: "memory")
#define PG8_WAIT_L(n) asm volatile("s_waitcnt lgkmcnt(" #n ")" ::: "memory")
#define PG8_BAR __builtin_amdgcn_s_barrier()
#define PG8_SCHED __builtin_amdgcn_sched_barrier(0)
    Unit cur, nxt; int ui = 0;
    if (!S.next(0, cur)) return;
    f32x4 acc[2][2][4][2];
#pragma unroll
    for (int a = 0; a < 2; ++a)
#pragma unroll
        for (int b = 0; b < 2; ++b)
#pragma unroll
            for (int m = 0; m < 4; ++m)
#pragma unroll
                for (int n = 0; n < 2; ++n) acc[a][b][m][n] = (f32x4){0.f, 0.f, 0.f, 0.f};
    bf16x8 At[4][2], B0[2][2], B1[2][2];
    S.a_ready(cur, wid, lane);
    PG8_SETOFF(cG, cur);
    {
        const char* a0 = PG8_AP(cur, 0); const char* a1 = PG8_AP(cur, 1); const char* cB = PG8_BP(cur, 0);
        PG8_STAGE_B(PG8_SB(0, 0), cB); PG8_STAGE_B(PG8_SB(0, 1), cB + hstepB); PG8_STAGE_AC(PG8_SA(0, 0), a0, 0); PG8_STAGE_AC(PG8_SA(0, 1), a0, 1);
        if (wr == 1) PG8_BAR;
        PG8_WAIT_V(2); PG8_BAR;
        PG8_STAGE_B(PG8_SB(1, 0), cB + kstep); PG8_STAGE_AC(PG8_SA(1, 0), a1, 0); PG8_STAGE_B(PG8_SB(1, 1), cB + hstepB + kstep);
        PG8_WAIT_V(6); PG8_BAR;
    }
    for (;;) {
        const bool has_next = S.next(ui + 1, nxt);
        if (!has_next) nxt = cur;
        if constexpr (GATHER) { PG8_SETOFF(nG, nxt); }
        for (int t = 0; t < nt; t += 2) {
            const bool last = (t == nt - 2);
            if (last && has_next) S.a_ready(nxt, wid, lane);
            if constexpr (MIDK) { if (t == ksplit) E.mid(acc, cur, wr, wc, fr, fq); }
            const char* a1 = PG8_AP(cur, t + 1);
            const char* a2 = last ? PG8_AP(nxt, 0) : PG8_AP(cur, t + 2); const char* b2 = last ? PG8_BP(nxt, 0) : PG8_BP(cur, t + 2);
            const char* a3 = last ? PG8_AP(nxt, 1) : PG8_AP(cur, t + 3); const char* b3 = b2 + kstep;
            PG8_LDB(B0, 0, 0); PG8_LDB(B1, 0, 1); PG8_SCHED; PG8_LDA(At, 0, 0); PG8_STAGE_AC(PG8_SA(1, 1), a1, 1);
            PG8_WAIT_V(8); PG8_WAIT_L(0); PG8_BAR; PG8_MMA(0, 0, At, B0); PG8_MMA(0, 1, At, B1); PG8_BAR; PG8_SCHED;
            PG8_LDA(At, 0, 1); PG8_STAGE_B(PG8_SB(0, 0), b2); PG8_STAGE_B(PG8_SB(0, 1), b2 + hstepB);
            if constexpr (GATHER) { PG8_STAGE_AS(PG8_SA(0, 0), a2, 0); } else { PG8_STAGE_AC(PG8_SA(0, 0), a2, 0); }
            PG8_WAIT_V(8); PG8_WAIT_L(0); PG8_BAR; PG8_MMA(1, 0, At, B0); PG8_MMA(1, 1, At, B1); PG8_BAR; PG8_SCHED;
            PG8_LDB(B0, 1, 0); PG8_LDB(B1, 1, 1); PG8_SCHED; PG8_LDA(At, 1, 0);
            if constexpr (GATHER) { PG8_STAGE_AS(PG8_SA(0, 1), a2, 1); } else { PG8_STAGE_AC(PG8_SA(0, 1), a2, 1); }
            PG8_WAIT_V(8); PG8_WAIT_L(0); PG8_BAR; PG8_MMA(0, 0, At, B0); PG8_MMA(0, 1, At, B1); PG8_BAR; PG8_SCHED;
            PG8_LDA(At, 1, 1); PG8_STAGE_B(PG8_SB(1, 0), b3); PG8_STAGE_B(PG8_SB(1, 1), b3 + hstepB);
            if constexpr (GATHER) { PG8_STAGE_AS(PG8_SA(1, 0), a3, 0); } else { PG8_STAGE_AC(PG8_SA(1, 0), a3, 0); }
            PG8_WAIT_V(8); PG8_WAIT_L(0); PG8_BAR; PG8_MMA(1, 0, At, B0); PG8_MMA(1, 1, At, B1); PG8_BAR; PG8_SCHED;
        }
        if (wr == 0) PG8_BAR;
        E(acc, cur, wr, wc, fr, fq);
        S.done(cur, lane);
        if (!has_next) break;
#pragma unroll
        for (int a = 0; a < 2; ++a)
#pragma unroll
            for (int b = 0; b < 2; ++b)
#pragma unroll
                for (int m = 0; m < 4; ++m)
#pragma unroll
                    for (int n = 0; n < 2; ++n) acc[a][b][m][n] = (f32x4){0.f, 0.f, 0.f, 0.f};
        cur = nxt; ++ui;
        if constexpr (GATHER) {
#pragma unroll
            for (int h = 0; h < 2; ++h)
#pragma unroll
                for (int i = 0; i < 2; ++i) cG[h][i] = nG[h][i]; }
        if (wr == 1) PG8_BAR;
    }
    PG8_WAIT_V(0);
    PG8_BAR;
#undef PG8_SETOFF
#undef PG8_AP
#undef PG8_BP
#undef PG8_SA
#undef PG8_SB
#undef PG8_ST2
#undef PG8_STAGE_B
#undef PG8_STAGE_AC
#undef PG8_STAGE_AS
#undef PG8_LDA
#undef PG8_LDB
#undef PG8_MMA
#undef PG8_WAIT_V
#undef PG8_WAIT_L
#undef PG8_BAR
#undef PG8_SCHED
}

struct DenseOrder {
    const char* A; const char* A2; const char* B; size_t tstepA, tstepB; int nM, nN, nwg, G, c;
    unsigned* wait_cnt; unsigned need; unsigned* pub_cnt; unsigned* tmo;
    __device__ bool next(int i, Unit& u) const {
        const long L = (long)i * G + c; if (L >= nwg) return false;
        int wgid = (int)L; { const int q = nwg / NXCD, r = nwg % NXCD, xcd = wgid % NXCD, off = wgid / NXCD; wgid = (xcd < r ? xcd * (q + 1) : r * (q + 1) + (xcd - r) * q) + off; }
        const int nig = WGM * nN, gid = wgid / nig, fm = gid * WGM, gsz = (nM - fm) < WGM ? (nM - fm) : WGM;
        u.pm = fm + ((wgid % nig) % gsz); u.pn = (wgid % nig) / gsz;
        u.a = A + (size_t)u.pm * tstepA; u.a2 = A2 + (size_t)u.pm * tstepA; u.b = B + (size_t)u.pn * tstepB; u.b2 = u.b; u.ridx = nullptr; u.nrows = 0; u.e = 0; u.lt = 0; return true;
    }
    __device__ __forceinline__ void a_ready(const Unit& u, int wid, int lane) const {
        if (wait_cnt) {
            if (wid == 0) { unsigned polls = 0;
                while ((unsigned)__builtin_amdgcn_readfirstlane(__hip_atomic_load(wait_cnt + 64 * u.pm, __ATOMIC_RELAXED, __HIP_MEMORY_SCOPE_AGENT)) < need) {
                    if (++polls > (1u << 20)) { if (lane == 0) __hip_atomic_store(tmo, 1u, __ATOMIC_RELAXED, __HIP_MEMORY_SCOPE_AGENT); break; }
                    __builtin_amdgcn_s_sleep(2); }
                __builtin_amdgcn_fence(__ATOMIC_ACQUIRE, "agent");
                asm volatile("s_waitcnt vmcnt(0)" ::: "memory"); }
            asm volatile("" ::: "memory"); __builtin_amdgcn_s_barrier(); asm volatile("" ::: "memory");
        }
    }
    __device__ __forceinline__ void done(const Unit& u, int lane) const {
        if (pub_cnt) { asm volatile("s_waitcnt vmcnt(0)" ::: "memory");
            if (lane == 0) __hip_atomic_fetch_add(pub_cnt + 64 * u.pm, 1u, __ATOMIC_RELAXED, __HIP_MEMORY_SCOPE_AGENT); }
    }
};
__device__ __forceinline__ void pair_of(int cl, int& ea, int& eb) { const int g = cl / 6, pi = cl - g * 6; const int a = pi < 3 ? 0 : (pi < 5 ? 1 : 2), b = pi < 3 ? pi + 1 : (pi < 5 ? pi - 1 : 3); ea = g * 4 + a; eb = g * 4 + b; }
__device__ __forceinline__ int class_of_tile(const LAS int* tb, int tau) { int c = 0;
#pragma unroll
    for (int j = 1; j < NCLS; ++j) c = (tau >= tb[j]) ? j : c;
    return c; }
struct MoeOrder1 {
    const LAS int* tb; const unsigned* cnt; const char* H2; const char* WGU; const int* TOK; int G, c;
    __device__ bool next(int i, Unit& u) const {
        const int L = i * G + c; const int tau = L >> 3; if (tau >= tb[NCLS]) return false;
        const int cl = class_of_tile(tb, tau), lt = tau - tb[cl]; int ea, eb; pair_of(cl, ea, eb);
        u.pm = tau; u.pn = L & 7; u.e = cl; u.lt = lt; u.nrows = (int)cnt[cl] - lt * 256; u.ridx = TOK + (size_t)cl * T + lt * 256;
        u.a = H2; u.a2 = H2; u.b = WGU + (size_t)((u.pn < 4) ? ea : eb) * ((size_t)1024 * D * 2) + (size_t)(u.pn & 3) * ((size_t)256 * D * 2); u.b2 = u.b; return true;
    }
    unsigned* tcnt;
    __device__ __forceinline__ void a_ready(const Unit&, int, int) const {}
    __device__ __forceinline__ void done(const Unit& u, int lane) const {
        asm volatile("s_waitcnt vmcnt(0)" ::: "memory");
        if (lane == 0) __hip_atomic_fetch_add(tcnt + 64 * u.pm, 1u, __ATOMIC_RELAXED, __HIP_MEMORY_SCOPE_AGENT);
    }
};
struct MoeOrder2 {
    const LAS int* tb; const unsigned* cnt; const char* ACT; const char* WD; const int* TOK; int G, c;
    __device__ bool next(int i, Unit& u) const {
        const int L = i * G + c; const int tau = L >> 2; if (tau >= tb[NCLS]) return false;
        const int cl = class_of_tile(tb, tau), lt = tau - tb[cl]; int ea, eb; pair_of(cl, ea, eb);
        u.pm = tau; u.pn = L & 3; u.e = cl; u.lt = lt; u.nrows = (int)cnt[cl] - lt * 256; u.ridx = TOK + (size_t)cl * T + lt * 256;
        u.a = ACT + (size_t)tau * ((size_t)256 * 1024 * 2); u.a2 = u.a;
        u.b = WD + (size_t)ea * ((size_t)1024 * DE * 2) + (size_t)u.pn * ((size_t)256 * DE * 2);
        u.b2 = WD + (size_t)eb * ((size_t)1024 * DE * 2) + (size_t)u.pn * ((size_t)256 * DE * 2) - (size_t)8 * 128; return true;
    }
    unsigned* tcnt; unsigned* tmo;
    __device__ __forceinline__ void a_ready(const Unit& u, int wid, int lane) const {
        if (wid == 0) {
            unsigned polls = 0;
            while ((unsigned)__builtin_amdgcn_readfirstlane(__hip_atomic_load(tcnt + 64 * u.pm, __ATOMIC_RELAXED, __HIP_MEMORY_SCOPE_AGENT)) < 64u) {
                if (++polls > (1u << 20)) { if (lane == 0) __hip_atomic_store(tmo, 1u, __ATOMIC_RELAXED, __HIP_MEMORY_SCOPE_AGENT); break; }
                __builtin_amdgcn_s_sleep(2); }
            __builtin_amdgcn_fence(__ATOMIC_ACQUIRE, "agent");
            asm volatile("s_waitcnt vmcnt(0)" ::: "memory");
        }
        asm volatile("" ::: "memory"); __builtin_amdgcn_s_barrier(); asm volatile("" ::: "memory");
    }
    __device__ __forceinline__ void done(const Unit&, int) const {}
};
}

using pg8::Unit;
typedef f32x4 AccT[2][2][4][2];
#define OPAQUE(x) asm volatile("" : "+v"(x))
struct EpiInProj {
    static constexpr int PERM = 2;
    bf16 *d0, *d1, *d2, *d3, *d4, *d5, *d6; const float* qg; const float* kg; float* vstatp; LAS float* tab;
    __device__ __forceinline__ void operator()(const AccT& acc, const Unit& u, int wr, int wc, int fr, int fq) const {
        const int seg = u.pn >> 2; char* base = (char*)(seg == 0 ? d0 : seg == 1 ? d1 : seg == 2 ? d2 : seg == 3 ? d3 : seg == 4 ? d4 : seg == 5 ? d5 : d6);
        unsigned ob = (unsigned)((u.pm * 256 + wr * 64 + (fr & ~1)) * D + (u.pn & 3) * 256 + wc * 64) * 2u + (unsigned)((fr & 1) * 64 + fq * 16); OPAQUE(ob);
        if (seg >= 5) {
            unsigned og = (unsigned)((u.pm * 256 + wr * 64 + fr) * D + (u.pn - 20) * 128 + wc * 32 + 8 * fq) * 2u; OPAQUE(og);
#pragma unroll
            for (int ai = 0; ai < 2; ++ai)
#pragma unroll
                for (int m = 0; m < 4; ++m) { const unsigned o = og + (unsigned)((ai * 128 + m * 16) * D * 2);
                    const f32x4 ea0 = exp2_4(acc[ai][0][m][0] * (-LOG2E)) + 1.0f, ea1 = exp2_4(acc[ai][0][m][1] * (-LOG2E)) + 1.0f;
                    const f32x4 eb0 = exp2_4(acc[ai][1][m][0] * (-LOG2E)) + 1.0f, eb1 = exp2_4(acc[ai][1][m][1] * (-LOG2E)) + 1.0f;
                    const f32x4 r0 = eb0 * rcp_4(ea0), r1 = eb1 * rcp_4(ea1), s0 = rcp_4(eb0), s1 = rcp_4(eb1);
                    u32x4 w; w.x = cvt_pk_bf16(r0[0], r0[1]); w.y = cvt_pk_bf16(r0[2], r0[3]); w.z = cvt_pk_bf16(r1[0], r1[1]); w.w = cvt_pk_bf16(r1[2], r1[3]);
                    __builtin_nontemporal_store(w, (u32x4*)((char*)d5 + o));
                    w.x = cvt_pk_bf16(s0[0], s0[1]); w.y = cvt_pk_bf16(s0[2], s0[3]); w.z = cvt_pk_bf16(s1[0], s1[1]); w.w = cvt_pk_bf16(s1[2], s1[3]);
                    __builtin_nontemporal_store(w, (u32x4*)((char*)d6 + o)); }
            return;
        }
        if (seg == 0 || seg == 4) {
            const bool odd = (fr & 1) != 0;
#pragma unroll
            for (int ai = 0; ai < 2; ++ai)
#pragma unroll
                for (int m = 0; m < 4; ++m) { const unsigned o = ob + (unsigned)((ai * 128 + m * 16) * D * 2);
                    u32x4 w[2];
#pragma unroll
                    for (int bj = 0; bj < 2; ++bj) { f32x4 v0 = acc[ai][bj][m][0], v1 = acc[ai][bj][m][1];
                        if (seg == 0) { v0 = gelu4(v0); v1 = gelu4(v1); }
                        w[bj].x = cvt_pk_bf16(v0[0], v0[1]); w[bj].y = cvt_pk_bf16(v0[2], v0[3]); w[bj].z = cvt_pk_bf16(v1[0], v1[1]); w[bj].w = cvt_pk_bf16(v1[2], v1[3]); }
                    st_lines<true>(base + o, D * 2, w[0], w[1], odd); }
            return;
        }
        if (seg == 1) stat_tile<true>(acc, u, wr, wc, fr, fq, base, ob, seg); else stat_tile<false>(acc, u, wr, wc, fr, fq, base, ob, seg);
    }
    template <bool GELU> __device__ __forceinline__ void stat_tile(const AccT& acc, const Unit& u, int wr, int wc, int fr, int fq, char* base, unsigned ob, int seg) const {
        int fr_ = fr, fq_ = fq; OPAQUE(fr_); OPAQUE(fq_);
        const int rowl = wr * 64 + fr_;
        const bool odd = (fr_ & 1) != 0;
        const int tslot = GELU ? wc : ((wc >> 1) * 1024 + (wc & 1) * 2);
        f32x4 g00, g01, g10, g11;
        if constexpr (!GELU) { const float* gv = (seg == 2 ? qg : kg) + (wc & 1) * 64 + 8 * fq_; const float gs = (seg == 2) ? QSCALE : 1.0f;
            g00 = *(const f32x4*)gv * gs; g01 = *(const f32x4*)(gv + 4) * gs; g10 = *(const f32x4*)(gv + 32) * gs; g11 = *(const f32x4*)(gv + 36) * gs; }
#pragma unroll
        for (int ai = 0; ai < 2; ++ai)
#pragma unroll
            for (int m = 0; m < 4; ++m) { const unsigned o = ob + (unsigned)((ai * 128 + m * 16) * D * 2);
                u32x4 w[2];
#pragma unroll
                for (int bj = 0; bj < 2; ++bj) { f32x4 v0 = acc[ai][bj][m][0], v1 = acc[ai][bj][m][1];
                    if constexpr (GELU) {
                        v0 = gelu4(v0); v1 = gelu4(v1);
                        w[bj].x = cvt_pk_bf16(v0[0], v0[1]); w[bj].y = cvt_pk_bf16(v0[2], v0[3]); w[bj].z = cvt_pk_bf16(v1[0], v1[1]); w[bj].w = cvt_pk_bf16(v1[2], v1[3]); }
                    float sq = (v0[0] * v0[0] + v0[1] * v0[1]) + (v0[2] * v0[2] + v0[3] * v0[3]) + (v1[0] * v1[0] + v1[1] * v1[1]) + (v1[2] * v1[2] + v1[3] * v1[3]);
                    sq = rows_sum(sq);
                    if (fq_ == 0) tab[(GELU ? bj * 1024 : bj) + (ai * 128 + m * 16 + rowl) * 4 + tslot] = sq; }
                if constexpr (GELU) st_lines<true>(base + o, D * 2, w[0], w[1], odd); }
        asm volatile("s_waitcnt lgkmcnt(0)" ::: "memory"); __builtin_amdgcn_s_barrier(); asm volatile("" ::: "memory");
        if constexpr (GELU) {
            if (wc == 0 && fq_ == 0) {
#pragma unroll
                for (int ai = 0; ai < 2; ++ai)
#pragma unroll
                    for (int m = 0; m < 4; ++m) { const int rl = ai * 128 + m * 16 + rowl;
                        const f32x4 t0 = *(const LAS f32x4*)(tab + (rl) * 4), t1 = *(const LAS f32x4*)(tab + (256 + rl) * 4);
                        vstatp[(size_t)(u.pn & 3) * T + u.pm * 256 + rl] = ((t0.x + t0.y) + (t0.z + t0.w)) + ((t1.x + t1.y) + (t1.z + t1.w)); } }
        } else {
#pragma unroll
            for (int ai = 0; ai < 2; ++ai)
#pragma unroll
                for (int m = 0; m < 4; ++m) { const unsigned o = ob + (unsigned)((ai * 128 + m * 16) * D * 2);
                    const int rl = ai * 128 + m * 16 + rowl;
                    const f32x4 t0 = *(const LAS f32x4*)(tab + ((wc >> 1) * 256 + rl) * 4);
                    const float rr = 1.0f / sqrtf(((t0.x + t0.y) + (t0.z + t0.w)) * (1.0f / DH) + EPS);
                    const f32x4 a0 = acc[ai][0][m][0] * rr * g00, a1 = acc[ai][0][m][1] * rr * g01, b0 = acc[ai][1][m][0] * rr * g10, b1 = acc[ai][1][m][1] * rr * g11;
                    u32x4 w0, w1; w0.x = cvt_pk_bf16(a0[0], a0[1]); w0.y = cvt_pk_bf16(a0[2], a0[3]); w0.z = cvt_pk_bf16(a1[0], a1[1]); w0.w = cvt_pk_bf16(a1[2], a1[3]);
                    w1.x = cvt_pk_bf16(b0[0], b0[1]); w1.y = cvt_pk_bf16(b0[2], b0[3]); w1.z = cvt_pk_bf16(b1[0], b1[1]); w1.w = cvt_pk_bf16(b1[2], b1[3]);
                    st_lines<true>(base + o, D * 2, w0, w1, odd);
                    asm volatile("" ::: "memory"); }
        }
    }
};
struct EpiProjAB {
    static constexpr int PERM = 2;
    const bf16* SA; const bf16* SB; bf16* MG;
    __device__ __forceinline__ void mid(AccT& acc, const Unit& u, int wr, int wc, int fr, int fq) const {
        unsigned ob = (unsigned)((u.pm * 256 + wr * 64 + (fr & ~1)) * D + u.pn * 256 + wc * 64) * 2u + (unsigned)((fr & 1) * 64 + fq * 16); OPAQUE(ob);
        const bool odd = (fr & 1) != 0;
#pragma unroll
        for (int ai = 0; ai < 2; ++ai)
#pragma unroll
            for (int m = 0; m < 4; ++m) { const unsigned o = ob + (unsigned)((ai * 128 + m * 16) * D * 2);
                u32x4 av[2]; ld_lines_fix(*(const u32x4*)((const char*)SA + o), *(const u32x4*)((const char*)SA + o + D * 2), odd, av[0], av[1]);
#pragma unroll
                for (int bj = 0; bj < 2; ++bj) { const u32x4 a = av[bj];
                    f32x4& v0 = acc[ai][bj][m][0]; f32x4& v1 = acc[ai][bj][m][1];
                    v0[0] *= bflo(a.x); v0[1] *= bfhi(a.x); v0[2] *= bflo(a.y); v0[3] *= bfhi(a.y);
                    v1[0] *= bflo(a.z); v1[1] *= bfhi(a.z); v1[2] *= bflo(a.w); v1[3] *= bfhi(a.w); }
                if (m == 3) asm volatile("" ::: "memory"); }
    }
    __device__ __forceinline__ void operator()(const AccT& acc, const Unit& u, int wr, int wc, int fr, int fq) const {
        unsigned os = (unsigned)((u.pm * 256 + wr * 64 + (fr & ~1)) * D + u.pn * 256 + wc * 64) * 2u + (unsigned)((fr & 1) * 64 + fq * 16); OPAQUE(os);
        const bool odd = (fr & 1) != 0;
#pragma unroll
        for (int ai = 0; ai < 2; ++ai) {
            u32x4 bv[4][2];
#pragma unroll
            for (int m = 0; m < 4; ++m)
#pragma unroll
                for (int bj = 0; bj < 2; ++bj) bv[m][bj] = *(const u32x4*)((const char*)SB + os + (unsigned)((ai * 128 + m * 16 + bj) * D * 2));
#pragma unroll
            for (int m = 0; m < 4; ++m) { u32x4 w[2], bb[2]; ld_lines_fix(bv[m][0], bv[m][1], odd, bb[0], bb[1]);
#pragma unroll
                for (int bj = 0; bj < 2; ++bj) { const u32x4 b = bb[bj]; const f32x4 v0 = acc[ai][bj][m][0], v1 = acc[ai][bj][m][1];
                    w[bj].x = cvt_pk_bf16(v0[0] * bflo(b.x), v0[1] * bfhi(b.x)); w[bj].y = cvt_pk_bf16(v0[2] * bflo(b.y), v0[3] * bfhi(b.y));
                    w[bj].z = cvt_pk_bf16(v1[0] * bflo(b.z), v1[1] * bfhi(b.z)); w[bj].w = cvt_pk_bf16(v1[2] * bflo(b.w), v1[3] * bfhi(b.w)); }
                st_lines_wt(MG, os + (unsigned)((ai * 128 + m * 16) * D * 2), D * 2, w[0], w[1], odd); }
            asm volatile("" ::: "memory"); }
    }
};
struct EpiOut {
    static constexpr int PERM = 2;
    const float* x; const float* mod; bf16* x1;
    __device__ __forceinline__ void operator()(const AccT& acc, const Unit& u, int wr, int wc, int fr, int fq) const {
        int col0 = u.pn * 256 + wc * 64 + 8 * fq; OPAQUE(col0);
        unsigned ob = (unsigned)((u.pm * 256 + wr * 64 + fr) * D + col0) * 4u; OPAQUE(ob);
        unsigned os = (unsigned)((u.pm * 256 + wr * 64 + (fr & ~1)) * D + u.pn * 256 + wc * 64) * 2u + (unsigned)((fr & 1) * 64 + fq * 16); OPAQUE(os);
        const bool odd = (fr & 1) != 0;
        const float* gate = (const float*)((const char*)mod + (unsigned)((((u.pm * 256) >> 11) * 6144 + 2048 + col0) * 4));
        f32x4 g[2][2];
#pragma unroll
        for (int bj = 0; bj < 2; ++bj)
#pragma unroll
            for (int n = 0; n < 2; ++n) g[bj][n] = *(const f32x4*)(gate + bj * 32 + n * 4);
#pragma unroll
        for (int ai = 0; ai < 2; ++ai) {
            f32x4 xv[4][2][2];
#pragma unroll
            for (int m = 0; m < 4; ++m)
#pragma unroll
                for (int bj = 0; bj < 2; ++bj)
#pragma unroll
                    for (int n = 0; n < 2; ++n) xv[m][bj][n] = *(const f32x4*)((const char*)x + ob + (unsigned)((ai * 128 + m * 16) * D * 4) + bj * 128 + n * 16);
#pragma unroll
            for (int m = 0; m < 4; ++m) { u32x4 w[2];
#pragma unroll
                for (int bj = 0; bj < 2; ++bj) { const f32x4 r0 = xv[m][bj][0] + g[bj][0] * acc[ai][bj][m][0], r1 = xv[m][bj][1] + g[bj][1] * acc[ai][bj][m][1];
                    w[bj].x = cvt_pk_bf16(r0[0], r0[1]); w[bj].y = cvt_pk_bf16(r0[2], r0[3]); w[bj].z = cvt_pk_bf16(r1[0], r1[1]); w[bj].w = cvt_pk_bf16(r1[2], r1[3]); }
                st_lines_wt(x1, os + (unsigned)((ai * 128 + m * 16) * D * 2), D * 2, w[0], w[1], odd); }
            asm volatile("" ::: "memory"); }
    }
};
struct EpiMoe1 {
    static constexpr int PERM = 1;
    bf16* ACT; const float* WW;
    __device__ __forceinline__ void operator()(const AccT& acc, const Unit& u, int wr, int wc, int fr, int fq) const {
        const int half = u.pn >> 2;
        unsigned ob = (unsigned)((u.pm * 256 + wr * 64 + fr) * 1024 + half * 512 + (u.pn & 3) * 128 + wc * 32 + 8 * fq) * 2u; OPAQUE(ob);
        const float* wl = WW + ((size_t)u.e * T + u.lt * 256) * 2 + half;
        int fr_ = fr; OPAQUE(fr_);
#pragma unroll
        for (int ai = 0; ai < 2; ++ai)
#pragma unroll
            for (int m = 0; m < 4; ++m) { const int lr = ai * 128 + wr * 64 + m * 16 + fr_; const float w = (lr < u.nrows) ? *(const float*)((const char*)wl + (unsigned)lr * 8u) : 0.f;
                const f32x4 g0 = acc[ai][0][m][0], g1 = acc[ai][0][m][1];
                const f32x4 a0 = g0 * sigmoid4(g0) * (acc[ai][1][m][0] * w), a1 = g1 * sigmoid4(g1) * (acc[ai][1][m][1] * w);
                u32x4 ww; ww.x = cvt_pk_bf16(a0[0], a0[1]); ww.y = cvt_pk_bf16(a0[2], a0[3]); ww.z = cvt_pk_bf16(a1[0], a1[1]); ww.w = cvt_pk_bf16(a1[2], a1[3]);
                st16_wt(ACT, ob + (unsigned)((ai * 128 + m * 16) * 1024 * 2), ww); }
    }
};
struct EpiMoe2 {
    static constexpr int PERM = 0;
    float* out; const float* mod; const bf16* x1;
    __device__ __forceinline__ void operator()(const AccT& acc, const Unit& u, int wr, int wc, int fr, int fq) const {
        int col0 = u.pn * 256 + wc * 32 + 4 * fq; OPAQUE(col0);
        int colx = u.pn * 256 + wc * 32 + 8 * (fq >> 1) + 16 * (fq & 1); OPAQUE(colx);
        int fr_ = fr; OPAQUE(fr_);
        const bool odd = (fr_ & 1) != 0;
        int tok[2][4];
#pragma unroll
        for (int ai = 0; ai < 2; ++ai)
#pragma unroll
            for (int m = 0; m < 4; ++m) { const int lr = ai * 128 + wr * 64 + m * 16 + fr_; tok[ai][m] = (lr < u.nrows) ? *(const int*)((const char*)u.ridx + (unsigned)lr * 4u) : -1; }
#pragma unroll
        for (int ai = 0; ai < 2; ++ai) {
            u32x4 xl[4][2];
#pragma unroll
            for (int m = 0; m < 4; ++m) { const bf16* xp = x1 + (size_t)(tok[ai][m] < 0 ? 0 : tok[ai][m]) * D + colx;
#pragma unroll
                for (int bj = 0; bj < 2; ++bj) xl[m][bj] = *(const u32x4*)(xp + bj * 128); }
#pragma unroll
            for (int m = 0; m < 4; ++m) { const int tk = tok[ai][m]; const int tn = (int)dpp_swap1((unsigned)tk); const int te = odd ? tn : tk, to = odd ? tk : tn;
                const float* gp = mod + (size_t)((tk < 0 ? 0 : tk) >> 11) * 6144 + 5120 + col0;
                float* pe = out + (size_t)(te < 0 ? 0 : te) * D + col0 + (odd ? 16 : 0); float* po = out + (size_t)(to < 0 ? 0 : to) * D + col0 + (odd ? 16 : 0);
#pragma unroll
                for (int bj = 0; bj < 2; ++bj) { const f32x4 g0 = *(const f32x4*)(gp + bj * 128), g1 = *(const f32x4*)(gp + bj * 128 + 16);
                    const auto s0 = __builtin_amdgcn_permlane16_swap(xl[m][bj].x, xl[m][bj].z, false, false); const auto s1 = __builtin_amdgcn_permlane16_swap(xl[m][bj].y, xl[m][bj].w, false, false);
                    const f32x4 x0 = {bflo(s0[0]), bfhi(s0[0]), bflo(s1[0]), bfhi(s1[0])}, x1v = {bflo(s0[1]), bfhi(s0[1]), bflo(s1[1]), bfhi(s1[1])};
                    const u32x4 r0 = __builtin_bit_cast(u32x4, x0 + g0 * acc[ai][bj][m][0]), r1 = __builtin_bit_cast(u32x4, x1v + g1 * acc[ai][bj][m][1]);
                    const u32x4 x = odd ? r0 : r1; u32x4 y; y.x = dpp_swap1(x.x); y.y = dpp_swap1(x.y); y.z = dpp_swap1(x.z); y.w = dpp_swap1(x.w);
                    if (te >= 0) *(u32x4*)(pe + bj * 128) = odd ? y : r0;
                    if (to >= 0) *(u32x4*)(po + bj * 128) = odd ? r1 : y; } }
            asm volatile("" ::: "memory"); }
    }
};

namespace att {
typedef float f32x16 __attribute__((ext_vector_type(16)));
typedef short s16x4 __attribute__((ext_vector_type(4)));
#define KSWZ(row, colB) ((row) * 256 + ((colB) ^ (((row) & 7) << 4)))
__device__ __forceinline__ int crow(int r, int hi) { return (r & 3) + 8 * (r >> 2) + 4 * hi; }
__device__ __forceinline__ int v_st(int k, int c) { const int kk = (k & ~0xC) | ((k & 4) << 1) | ((k & 8) >> 1); return ((kk >> 3) * 4 + (c >> 5)) * 512 + ((kk & 7) * 32 + (c & 31)) * 2; }
__device__ __forceinline__ int v_rd_base(int lane) { return ((lane & 3) << 3) | (((lane >> 2) & 3) << 6) | (((lane >> 4) & 1) << 5) | (((lane >> 5) & 1) << 8); }
constexpr int v_rd_off(int d0, int ks, int half) { return d0 * 512 + ks * 4096 + half * 2048; }
template <int OFF> __device__ __forceinline__ s16x4 tr_read(int vb) {
    s16x4 r; asm volatile("ds_read_b64_tr_b16 %0, %1 offset:%2" : "=&v"(r) : "v"(vb), "i"(OFF) : "memory"); return r;
}
template <int D0> __device__ __forceinline__ void pv_two(f32x16& oa, f32x16& ob2, int vb, bf16x8 pa0, bf16x8 pa1) {
    const s16x4 l0 = tr_read<v_rd_off(D0, 0, 0)>(vb), h0 = tr_read<v_rd_off(D0, 0, 1)>(vb), l1 = tr_read<v_rd_off(D0, 1, 0)>(vb), h1 = tr_read<v_rd_off(D0, 1, 1)>(vb);
    const s16x4 m0 = tr_read<v_rd_off(D0 + 1, 0, 0)>(vb), n0 = tr_read<v_rd_off(D0 + 1, 0, 1)>(vb), m1 = tr_read<v_rd_off(D0 + 1, 1, 0)>(vb), n1 = tr_read<v_rd_off(D0 + 1, 1, 1)>(vb);
    asm volatile("s_waitcnt lgkmcnt(0)" ::: "memory"); __builtin_amdgcn_sched_barrier(0);
#define PKV(L_, H_) (bf16x8){L_[0], L_[1], L_[2], L_[3], H_[0], H_[1], H_[2], H_[3]}
    oa = __builtin_amdgcn_mfma_f32_32x32x16_bf16(pa0, PKV(l0, h0), oa, 0, 0, 0);
    ob2 = __builtin_amdgcn_mfma_f32_32x32x16_bf16(pa0, PKV(m0, n0), ob2, 0, 0, 0);
    oa = __builtin_amdgcn_mfma_f32_32x32x16_bf16(pa1, PKV(l1, h1), oa, 0, 0, 0);
    ob2 = __builtin_amdgcn_mfma_f32_32x32x16_bf16(pa1, PKV(m1, n1), ob2, 0, 0, 0);
#undef PKV
}
template <int MODE>
__device__ __forceinline__ void class_block(f32x16 (&o)[4], float& lsum, const bf16x8 (&qr)[8], int kbase  , int vb  ,
                                            int r32, int hi, int Lq, int rel, int r, int cls, float negM2) {
    f32x16 p;
#pragma unroll
    for (int i = 0; i < 16; ++i) p[i] = negM2;
    int r32_ = r32, hi_ = hi; OPAQUE(r32_); OPAQUE(hi_);
    bf16x8 kf[8];
#pragma unroll
    for (int d0 = 0; d0 < 8; ++d0) { const int cb = (d0 * 16 + hi_ * 8) * 2; kf[d0] = *(const LAS bf16x8*)((LAS unsigned char*)(size_t)0 + kbase + KSWZ(r32_, cb)); }
#pragma unroll
    for (int d0 = 0; d0 < 8; ++d0) p = __builtin_amdgcn_mfma_f32_32x32x16_bf16(kf[d0], qr[d0], p, 0, 0, 0);
    const int Bv = 128 * rel + (r - cls);
    const bool same = (cls == r);
    const int lo1 = -(Bv >> 2), hi1 = (128 - Bv) >> 2;
    const int lo2 = same ? lo1 : 64, hi2 = same ? ((512 - Bv) >> 2) : -64;
    float ls = 0.f;
#pragma unroll
    for (int i = 0; i < 16; ++i) { const int creg = (i & 3) + 8 * (i >> 2); const int Dv = Lq - creg;
        const float e = __builtin_amdgcn_exp2f(p[i]);
        const bool m3 = ((Lq & 3) == (creg & 3));
        float w;
        if constexpr (MODE == 0) { w = m3 ? 1.f : 0.f; }
        else if constexpr (MODE == 2) { w = ((Dv >= lo1) & (Dv <= hi1)) ? 1.f : 0.f; }
        else { w = (((Dv >= lo1) & (Dv <= hi1)) ? 1.f : 0.f) + (((Dv >= lo2) & (Dv <= hi2)) ? 1.f : 0.f) + (((Dv >= lo2) & m3) ? 1.f : 0.f); }
        p[i] = e * w; ls += p[i]; }
    lsum += ls;
    bf16x8 pa0, pa1;
#define PK4(P_, BASE, OUT) do { unsigned a0 = cvt_pk_bf16(P_[BASE + 0], P_[BASE + 1]), a1 = cvt_pk_bf16(P_[BASE + 2], P_[BASE + 3]);   \
        unsigned b0 = cvt_pk_bf16(P_[BASE + 4], P_[BASE + 5]), b1 = cvt_pk_bf16(P_[BASE + 6], P_[BASE + 7]);                              \
        auto r0 = __builtin_amdgcn_permlane32_swap(a0, b0, false, false); auto r1 = __builtin_amdgcn_permlane32_swap(a1, b1, false, false); \
        u32x4 w_ = {r0[0], r1[0], r0[1], r1[1]}; OUT = *reinterpret_cast<bf16x8*>(&w_); } while (0)
    PK4(p, 0, pa0); PK4(p, 8, pa1);
#undef PK4
    pv_two<0>(o[0], o[1], vb, pa0, pa1); pv_two<2>(o[2], o[3], vb, pa0, pa1);
}
__device__ __forceinline__ void attn_phase(const bf16* Kb, const bf16* Vb, bf16* QO, const float* qg, const float* kg, unsigned char* lds_g, int vcu, int G, const int TID) {
    const int tid = TID, wid = __builtin_amdgcn_readfirstlane(tid >> 6), lane = tid & 63, r32 = lane & 31, hi = lane >> 5;
    const int r = wid & 3, hf = wid >> 2;
    const int lds0 = (int)(size_t)(LAS unsigned char*)lds_g;
    float* li_l = (float*)(lds_g + LDS_EPI) + wid * 64;
    float gq = fmaxf(fabsf(qg[lane]), fabsf(qg[lane + 64])), gk = fmaxf(fabsf(kg[lane]), fabsf(kg[lane + 64]));
#pragma unroll
    for (int o_ = 1; o_ < 64; o_ <<= 1) { gq = fmaxf(gq, __shfl_xor(gq, o_)); gk = fmaxf(gk, __shfl_xor(gk, o_)); }
    const float negM2 = -11.313708498984761f * LOG2E * gq * gk;
    const int Lq = r32 - 4 * hi;
    const int sr = tid >> 4, sc = (tid & 15) * 8;
    const int scls = sr & 3;
    for (int it = vcu; it < 1024; it += G) {
        const int j = it & 255, rr = it >> 8, bh = (j >> 3) * 4 + rr, kq = j & 7;
        const int qt = (rr & 1) ? 7 - kq : kq; const bool desc = (rr & 1) != 0;
        const int b = bh >> 3, h = bh & 7, t0 = 256 * qt, cq = 2 * qt + hf, nch = 2 * qt + 2;
        const size_t hb = (size_t)b * S * D + h * DH;
        const bf16* Kh = Kb + hb; const bf16* Vh = Vb + hb; bf16* Qh = QO + hb;
        bf16x8 qr[8];
        { const bf16* Qw = Qh + (size_t)(t0 + 128 * hf + r + 4 * r32) * D + hi * 8;
#pragma unroll
          for (int d0 = 0; d0 < 8; ++d0) qr[d0] = *(const bf16x8*)(Qw + d0 * 16); }
        f32x16 o[4];
#pragma unroll
        for (int d = 0; d < 4; ++d)
#pragma unroll
            for (int i = 0; i < 16; ++i) o[d][i] = 0.f;
        float lsum = 0.f;
#define SDMA(c, bf) do { int ln_ = lane; OPAQUE(ln_); const int cls_ = wid >> 1, w1_ = wid & 1; \
            const unsigned cbase_ = (unsigned)(128 * (c)) * 2048u; \
            _Pragma("unroll") for (int i_ = 0; i_ < 4; ++i_) { \
                const int kidx_ = 16 * w1_ + 4 * i_ + (ln_ >> 4); const int pc_ = (ln_ & 15) ^ (kidx_ & 7); \
                const unsigned ko_ = cbase_ + (unsigned)(4 * kidx_ + cls_) * 2048u + (unsigned)pc_ * 16u; \
                __builtin_amdgcn_global_load_lds((const unsigned*)((const char*)Kh + ko_), (LAS unsigned*)(L3 + (bf) * 65536 + wid * 4096 + i_ * 1024), 16, 0, 0); \
                const int k_ = 16 * w1_ + 8 * ((ln_ >> 4) & 1) + 4 * (i_ >> 1) + ((ln_ >> 2) & 3); const int c_ = 32 * (2 * (i_ & 1) + (ln_ >> 5)) + 8 * (ln_ & 3); \
                const unsigned vo_ = cbase_ + (unsigned)(4 * k_ + cls_) * 2048u + (unsigned)c_ * 2u; \
                __builtin_amdgcn_global_load_lds((const unsigned*)((const char*)Vh + vo_), (LAS unsigned*)(L3 + (bf) * 65536 + 32768 + wid * 4096 + i_ * 1024), 16, 0, 0); } } while (0)
        LAS unsigned char* L3 = (LAS unsigned char*)lds_g;
        SDMA((desc ? nch - 1 : 0), 0); __syncthreads();
        for (int ci = 0; ci < nch; ++ci) {
            const int bf = ci & 1; const int c = desc ? nch - 1 - ci : ci;
            if (ci + 1 < nch) SDMA((desc ? c - 1 : c + 1), bf ^ 1);
            const int rel = cq - c;
            const int kb0 = lds0 + bf * 65536, vb0 = lds0 + bf * 65536 + 32768 + v_rd_base(lane);
            if (rel >= 5) { class_block<0>(o, lsum, qr, kb0 + r * 8192, vb0 + r * 8192, r32, hi, Lq, rel, r, r, negM2); }
            else if (rel >= 0) {
                class_block<1>(o, lsum, qr, kb0 + r * 8192, vb0 + r * 8192, r32, hi, Lq, rel, r, r, negM2);
                if (rel < 2) {
#pragma unroll 1
                    for (int k = 1; k < 4; ++k) { const int cls = (r + k) & 3; class_block<2>(o, lsum, qr, kb0 + cls * 8192, vb0 + cls * 8192, r32, hi, Lq, rel, r, cls, negM2); } }
            }
            __syncthreads();
        }
#undef SDMA
        { const float lt = lsum + __shfl_xor(lsum, 32);
          if (hi == 0) li_l[r32] = lt; }
        asm volatile("s_waitcnt lgkmcnt(0)" ::: "memory");
        unsigned short* ot = (unsigned short*)(lds_g + wid * 8704);
#pragma unroll
        for (int i = 0; i < 16; ++i) { const int q = crow(i, hi); const float rli = __builtin_amdgcn_rcpf(li_l[q]);
#pragma unroll
            for (int d0 = 0; d0 < 4; ++d0) ot[q * 136 + d0 * 32 + r32] = (unsigned short)f2bf(o[d0][i] * rli); }
        asm volatile("s_waitcnt lgkmcnt(0)" ::: "memory");
#pragma unroll
        for (int jj = 0; jj < 8; ++jj) { const int idx = jj * 64 + lane, q = idx >> 4, pc = idx & 15;
            const u32x4 v = *(const u32x4*)(ot + q * 136 + pc * 8);
            *(u32x4*)(Qh + (size_t)(t0 + 128 * hf + r + 4 * q) * D + pc * 8) = v; }
        __syncthreads();
    }
}
#undef KSWZ
}


namespace sgu {
using att::f32x16; using att::s16x4; using att::tr_read; using att::v_rd_base; using att::crow;
template <int KS> __device__ __forceinline__ void kstep(f32x16& a0, f32x16& a1, int vb, const bf16x8 af, int nks) {
    if (KS < nks) {
        const s16x4 l0 = tr_read<KS * 4096>(vb), h0 = tr_read<KS * 4096 + 2048>(vb), l1 = tr_read<KS * 4096 + 512>(vb), h1 = tr_read<KS * 4096 + 2048 + 512>(vb);
        asm volatile("s_waitcnt lgkmcnt(0)" ::: "memory"); __builtin_amdgcn_sched_barrier(0);
#define PKV(L_, H_) (bf16x8){L_[0], L_[1], L_[2], L_[3], H_[0], H_[1], H_[2], H_[3]}
        a0 = __builtin_amdgcn_mfma_f32_32x32x16_bf16(af, PKV(l0, h0), a0, 0, 0, 0);
        a1 = __builtin_amdgcn_mfma_f32_32x32x16_bf16(af, PKV(l1, h1), a1, 0, 0, 0);
#undef PKV
    }
}
__device__ __forceinline__ void sgu_phase(const bf16* GU, const bf16* GV, const float* vstat, const float* gn, const bf16* SW, const float* sgu_b, bf16* SG, unsigned char* lds_g, int vcu, int G, const int TID) {
    const int tid = TID, wid = __builtin_amdgcn_readfirstlane(tid >> 6), lane = tid & 63, r32 = lane & 31, hi = lane >> 5;
    const int tb = wid & 3, ch2 = wid >> 2;
    LAS unsigned char* L3 = (LAS unsigned char*)lds_g;
    const int lds0 = (int)(size_t)L3;
    float* ot = (float*)(lds_g + 65536 + wid * 8704);
    float* rsl = (float*)(lds_g + 135168);
    constexpr int NIT = (T / 128) * 8;
#define GDMA(item, bf) do { const int cj_ = (item) >> 3, g_ = (item) & 7; int ln_ = lane; OPAQUE(ln_); \
        _Pragma("unroll") for (int i_ = 0; i_ < 4; ++i_) { const int sp_ = 4 * wid + i_; \
            const int kk_ = 8 * (sp_ >> 1) + ((ln_ & 31) >> 2); const int k_ = (kk_ & ~0xC) | ((kk_ & 4) << 1) | ((kk_ & 8) >> 1); \
            const int c_ = 32 * (2 * (sp_ & 1) + (ln_ >> 5)) + 8 * (ln_ & 3); \
            const unsigned go_ = (unsigned)((cj_ * 128 + k_) * D + g_ * 128 + c_) * 2u; \
            __builtin_amdgcn_global_load_lds((const unsigned*)((const char*)GV + go_), (LAS unsigned*)(L3 + (bf) * 32768 + sp_ * 1024), 16, 0, 0); } } while (0)
    int it = vcu, bf = 0;
    if (it < NIT) { GDMA(it, 0);
        if (tid < 128) { const float* vp = vstat + (it >> 3) * 128 + tid; rsl[tid] = 1.0f / sqrtf(((vp[0] + vp[T]) + (vp[2 * T] + vp[3 * T])) * (1.0f / D) + EPS); } }
    int g_have = -1; u32x4 wvs[8]; f32x4 bs4[4]; float gn0 = 0.f, gn1 = 0.f;
#pragma unroll
    for (int i = 0; i < 8; ++i) wvs[i] = (u32x4){0u, 0u, 0u, 0u};
#pragma unroll
    for (int i = 0; i < 4; ++i) bs4[i] = (f32x4){0.f, 0.f, 0.f, 0.f};
    for (; it < NIT; it += G, bf ^= 1) {
        __syncthreads();
        const bool more = it + G < NIT;
        const int cj = it >> 3, g = it & 7, row0 = cj * 128;
        if (g != g_have) { g_have = g; const bf16* wrow_ = SW + ((size_t)g * 128 + 32 * tb + r32) * 128 + 8 * hi;
#pragma unroll
            for (int i = 0; i < 8; ++i) wvs[i] = *(const u32x4*)(wrow_ + 16 * i);
#pragma unroll
            for (int i = 0; i < 4; ++i) bs4[i] = *(const f32x4*)(sgu_b + g * 128 + 32 * tb + 8 * i + 4 * hi);
            gn0 = gn[g * 128 + ch2 * 64 + r32]; gn1 = gn[g * 128 + ch2 * 64 + 32 + r32]; }
        f32x4 vn = {0.f, 0.f, 0.f, 0.f};
        if (more && tid < 128) { const float* vp = vstat + ((it + G) >> 3) * 128 + tid; vn = (f32x4){vp[0], vp[T], vp[2 * T], vp[3 * T]}; }
        u32x4 uv[4];
#pragma unroll
        for (int jj = 0; jj < 4; ++jj) { const int idx = jj * 64 + lane, q = idx >> 3, pc = idx & 7; uv[jj] = *(const u32x4*)(GU + (size_t)(row0 + 32 * tb + q) * D + g * 128 + ch2 * 64 + pc * 8); }
        asm volatile("" ::: "memory");
        if (more) GDMA(it + G, bf ^ 1);
        const int nks = 2 * tb + 2;
        f32x16 a0, a1;
#pragma unroll
        for (int i = 0; i < 16; ++i) { a0[i] = 0.f; a1[i] = 0.f; }
        const int vb = lds0 + bf * 32768 + ch2 * 1024 + v_rd_base(lane);
        const float* rsp = rsl + bf * 128 + 8 * hi;
#define KSTEP(KS) do { if (KS < nks) { const u32x4 wv = wvs[KS]; const f32x4 r0 = *(const f32x4*)(rsp + 16 * KS), r1 = *(const f32x4*)(rsp + 16 * KS + 4); \
            u32x4 av; av.x = cvt_pk_bf16(bflo(wv.x) * r0.x, bfhi(wv.x) * r0.y); av.y = cvt_pk_bf16(bflo(wv.y) * r0.z, bfhi(wv.y) * r0.w); \
            av.z = cvt_pk_bf16(bflo(wv.z) * r1.x, bfhi(wv.z) * r1.y); av.w = cvt_pk_bf16(bflo(wv.w) * r1.z, bfhi(wv.w) * r1.w); \
            kstep<KS>(a0, a1, vb, *reinterpret_cast<bf16x8*>(&av), nks); } } while (0)
        KSTEP(0); KSTEP(1); KSTEP(2); KSTEP(3); KSTEP(4); KSTEP(5); KSTEP(6); KSTEP(7);
#undef KSTEP
#pragma unroll
        for (int i4 = 0; i4 < 4; ++i4)
#pragma unroll
            for (int e = 0; e < 4; ++e) { const int i = 4 * i4 + e, q = crow(i, hi); ot[q * 68 + r32] = a0[i] * gn0 + bs4[i4][e]; ot[q * 68 + 32 + r32] = a1[i] * gn1 + bs4[i4][e]; }
        asm volatile("s_waitcnt lgkmcnt(0)" ::: "memory");
#pragma unroll
        for (int jj = 0; jj < 4; ++jj) { const int idx = jj * 64 + lane, q = idx >> 3, pc = idx & 7;
            const f32x4 m0 = *(const f32x4*)(ot + q * 68 + pc * 8), m1 = *(const f32x4*)(ot + q * 68 + pc * 8 + 4);
            const size_t go = (size_t)(row0 + 32 * tb + q) * D + g * 128 + ch2 * 64 + pc * 8;
            const u32x4 u_ = uv[jj];
            u32x4 w; w.x = cvt_pk_bf16(bflo(u_.x) * m0.x, bfhi(u_.x) * m0.y); w.y = cvt_pk_bf16(bflo(u_.y) * m0.z, bfhi(u_.y) * m0.w);
            w.z = cvt_pk_bf16(bflo(u_.z) * m1.x, bfhi(u_.z) * m1.y); w.w = cvt_pk_bf16(bflo(u_.w) * m1.z, bfhi(u_.w) * m1.w);
            *(u32x4*)(SG + go) = w; }
        if (more && tid < 128) rsl[(bf ^ 1) * 128 + tid] = 1.0f / sqrtf(((vn.x + vn.y) + (vn.z + vn.w)) * (1.0f / D) + EPS);
        asm volatile("s_waitcnt lgkmcnt(0)" ::: "memory");
    }
#undef GDMA
    __syncthreads();
}
}

#define XB_TMO      128
#define XB_XCNT(j)  (256  + 64 * (j))
#define XB_XSUB(j)  (1280 + 64 * (j))
#define XB_XGEN(j)  (2304 + 64 * (j))
#define XB_TOP      3328
#define XB_TOPGEN   3392
#define XCD_BAR_WORDS 3456
#define XB_SPIN_CAP (1u << 18)

__device__ __forceinline__ unsigned xb_ld(unsigned* p)              { return __hip_atomic_load(p, __ATOMIC_RELAXED, __HIP_MEMORY_SCOPE_AGENT); }
__device__ __forceinline__ unsigned xb_add(unsigned* p, unsigned v) { return __hip_atomic_fetch_add(p, v, __ATOMIC_RELAXED, __HIP_MEMORY_SCOPE_AGENT); }
__device__ __forceinline__ unsigned xb_xcc_id() { return (unsigned)__builtin_amdgcn_s_getreg((3 << 11) | 20) & 0xFu; }
#define XB_SPIN(cond, bar) do { unsigned _sp = 0; while (cond) { __builtin_amdgcn_s_sleep(1); \
    if ((++_sp & 255u) == 0u) { if (xb_ld(&(bar)[XB_TMO])) break; if (_sp > XB_SPIN_CAP) { atomicAdd(&(bar)[XB_TMO], 1u); break; } } } } while (0)

struct XcdBarrier {
    unsigned* bar; unsigned x;
    volatile LAS unsigned* st;
    bool w0;
};

__device__ __forceinline__ XcdBarrier xcd_barrier_post(unsigned* bar, volatile LAS unsigned* st, bool w0) {
    XcdBarrier b; b.bar = bar; b.x = xb_xcc_id(); b.st = st; b.w0 = w0;
    if (lane_id_fresh() == 0 && b.w0) (void)xb_add(&bar[XB_XCNT(b.x)], 1u);
    return b;
}
__device__ __forceinline__ void xcd_barrier_complete(unsigned* bar, unsigned x, unsigned& nloc, unsigned& nx) {
    const unsigned G = gridDim.x * gridDim.y * gridDim.z;
    unsigned sum, cnt, mine, sp = 0u;
    for (;;) {
        sum = 0u; cnt = 0u; mine = 0u;
#pragma unroll
        for (unsigned j = 0; j < 16; ++j) { const unsigned c = xb_ld(&bar[XB_XCNT(j)]); sum += c; cnt += (c > 0u) ? 1u : 0u; mine = (j == x) ? c : mine; }
        if (sum == G) break;
        __builtin_amdgcn_s_sleep(1);
        if ((++sp & 255u) == 0u) { if (xb_ld(&bar[XB_TMO])) break; if (sp > XB_SPIN_CAP) { atomicAdd(&bar[XB_TMO], 1u); break; } }
    }
    nloc = mine > 0u ? mine : 1u; nx = cnt > 0u ? cnt : 1u;
}

struct NoFill { __device__ __forceinline__ void operator()() const {} };
template <class Fill>
__device__ __forceinline__ void xcd_barrier(const XcdBarrier& b, const Fill& fill) {
    asm volatile("s_waitcnt vmcnt(0)" ::: "memory");
    __syncthreads();
    if (!b.w0) fill();
    if (lane_id_fresh() == 0 && b.w0) {
        unsigned* bar = b.bar;
        __builtin_amdgcn_s_waitcnt(0);
        unsigned nloc = b.st[0], nx = b.st[1];
        if (nloc == 0u) { xcd_barrier_complete(bar, b.x, nloc, nx); b.st[0] = nloc; b.st[1] = nx; }
        const unsigned old = xb_add(&bar[XB_XSUB(b.x)], 1u);
        const unsigned gen = old / nloc;
        if (old + 1u == (gen + 1u) * nloc) {
            __builtin_amdgcn_fence(__ATOMIC_RELEASE, "agent");
            asm volatile("s_waitcnt vmcnt(0)" ::: "memory");
            const unsigned og = xb_add(&bar[XB_TOP], 1u);
            const unsigned tg = og / nx;
            if (og + 1u == (tg + 1u) * nx) xb_add(&bar[XB_TOPGEN], 1u);
            else XB_SPIN(xb_ld(&bar[XB_TOPGEN]) == tg, bar);
            __builtin_amdgcn_fence(__ATOMIC_ACQUIRE, "agent");
            xb_add(&bar[XB_XGEN(b.x)], 1u);
            asm volatile("s_waitcnt vmcnt(0)" ::: "memory");
        } else {
            XB_SPIN(xb_ld(&bar[XB_XGEN(b.x)]) == gen, bar);
            __builtin_amdgcn_fence(__ATOMIC_ACQUIRE, "agent");
            asm volatile("s_waitcnt vmcnt(0)" ::: "memory");
        }
    }
    __syncthreads();
}


struct Ptrs {
    const float *x, *c, *w_ada, *b_ada, *g1, *w_in, *sgn, *sgu_w, *sgu_b, *qg, *kg, *wa, *wb, *wo, *g2, *w_rg, *b_rg, *w_re, *b_re, *wg, *wu, *wd;
    float* out; unsigned char* ws;
};
__device__ __forceinline__ void transpose_item(const float* W, int N, int k0, int n0, bf16* dst  , int ldd, float* scr, int lane) {
    float wv[32];
#pragma unroll
    for (int i = 0; i < 32; ++i) wv[i] = W[(size_t)(k0 + 2 * i + (lane >> 5)) * N + n0 + (lane & 31)];
#pragma unroll
    for (int i = 0; i < 32; ++i) scr[(2 * i + (lane >> 5)) * 33 + (lane & 31)] = wv[i];
    asm volatile("s_waitcnt lgkmcnt(0)" ::: "memory");
    const int c = lane & 7;
#pragma unroll
    for (int j = 0; j < 4; ++j) { const int n = (lane >> 3) + 8 * j; const float* s = scr + (8 * c) * 33 + n;
        u32x4 o; o.x = pk2(s[0 * 33], s[1 * 33]); o.y = pk2(s[2 * 33], s[3 * 33]); o.z = pk2(s[4 * 33], s[5 * 33]); o.w = pk2(s[6 * 33], s[7 * 33]);
        *(u32x4*)(dst + (size_t)n * ldd + 8 * c) = o; }
    asm volatile("s_waitcnt lgkmcnt(0)" ::: "memory");
}


__device__ __forceinline__ void p_mod(const Ptrs& P, unsigned char* lds, int bid, int G, const int TID) {
    float* sc = (float*)lds;
    float* red = sc + 1024 * 16;
    const int tid = TID, wave = tid >> 6, lane = tid & 63, col = lane & 31, kh = lane >> 5;
    float* mod = (float*)(P.ws + WS_MOD);
    if (bid >= 6144 / 32) return;
    for (int i = tid; i < 16 * 1024; i += 512) { const int b = i >> 10, k = i & 1023; const float v = P.c[i]; sc[k * 16 + b] = v / (1.0f + __expf(-v)); }
    __syncthreads();
    for (int item = bid; item < 6144 / 32; item += G) {
        const int n0 = item * 32;
        float acc[16];
#pragma unroll
        for (int b = 0; b < 16; ++b) acc[b] = 0.f;
        for (int k0 = wave * 128 + kh * 64; k0 < wave * 128 + kh * 64 + 64; k0 += 8) {
            float wv[8];
#pragma unroll
            for (int u = 0; u < 8; ++u) wv[u] = P.w_ada[(size_t)(k0 + u) * 6144 + n0 + col];
#pragma unroll
            for (int u = 0; u < 8; ++u) { const f32x4* sp = (const f32x4*)(sc + (k0 + u) * 16);
#pragma unroll
                for (int q = 0; q < 4; ++q) { const f32x4 s4 = sp[q]; acc[4 * q + 0] += s4.x * wv[u]; acc[4 * q + 1] += s4.y * wv[u]; acc[4 * q + 2] += s4.z * wv[u]; acc[4 * q + 3] += s4.w * wv[u]; } }
        }
#pragma unroll
        for (int b = 0; b < 16; ++b) { acc[b] += __shfl_xor(acc[b], 32); if (kh == 0) red[(wave * 16 + b) * 32 + col] = acc[b]; }
        __syncthreads();
        { const int b = tid >> 5, l = tid & 31; float sacc = P.b_ada[n0 + l];
#pragma unroll
            for (int w = 0; w < 8; ++w) sacc += red[(w * 16 + b) * 32 + l];
            mod[b * 6144 + n0 + l] = sacc; }
        __syncthreads();
    }
}
__device__ __forceinline__ void p_prep(const Ptrs& P, unsigned char* lds, int bid, int G, const int TID) {
    const int wave = TID >> 6, lane = TID & 63;
    float* scr = (float*)lds + wave * (64 * 33);
    const int gw = bid * 8 + wave, NGW = G * 8;
    constexpr int I_IN = (D / 64) * (INW / 32), I_SQ = (D / 64) * (D / 32);
    constexpr int NIT = I_IN + 3 * I_SQ;
    bf16* WIN = (bf16*)(P.ws + WS_WIN); bf16* WAB = (bf16*)(P.ws + WS_WAB); bf16* WO = (bf16*)(P.ws + WS_WO);
    const bool split = (G == 256) && (NIT == 192 * 8 * 2 + 64 * 8 * 4);
    const int nmine = split ? (bid < 192 ? 2 : 4) : (NIT - gw + NGW - 1) / NGW;
    const int first = split ? (bid < 192 ? gw * 2 : 192 * 8 * 2 + (gw - 192 * 8) * 4) : gw, step = split ? 1 : NGW;
    for (int n_ = 0; n_ < nmine; ++n_) { const int it = first + n_ * step; if (it >= NIT) break;
        int r = it;
        if (r < I_IN) { const int nblk = INW / 32, kb = r / nblk, nb = r % nblk; const int n0 = 32 * nb;
            const int drow = n0 < 5120 ? n0 : (n0 < 6144 ? 5120 + 256 * ((n0 - 5120) >> 7) + 2 * ((n0 - 5120) & 127) : 5120 + 256 * ((n0 - 6144) >> 7) + 2 * ((n0 - 6144) & 127) + 32);
            transpose_item(P.w_in, INW, 64 * kb, n0, WIN + (size_t)drow * D + 64 * kb, D, scr, lane); continue; } r -= I_IN;
        if (r < I_SQ) { const int nblk = D / 32, kb = r / nblk, nb = r % nblk; transpose_item(P.wa, D, 64 * kb, 32 * nb, WAB + (size_t)(32 * nb) * 2048 + 64 * kb, 2048, scr, lane); continue; } r -= I_SQ;
        if (r < I_SQ) { const int nblk = D / 32, kb = r / nblk, nb = r % nblk; transpose_item(P.wb, D, 64 * kb, 32 * nb, WAB + (size_t)(32 * nb) * 2048 + 1024 + 64 * kb, 2048, scr, lane); continue; } r -= I_SQ;
        { const int nblk = D / 32, kb = r / nblk, nb = r % nblk; transpose_item(P.wo, D, 64 * kb, 32 * nb, WO + (size_t)(32 * nb) * D + 64 * kb, D, scr, lane); }
    }
    bf16* SW = (bf16*)(P.ws + WS_SW);
    for (int i = bid * 512 + TID; i < 8 * 128 * 128; i += G * 512) { const int s = i & 127, t = (i >> 7) & 127; SW[i] = (bf16)f2bf(s <= t ? P.sgu_w[i] : 0.f); }
}
constexpr int MOE_PREP_ITEMS = NE * (2 * (D / 64) * (DE / 32) + (DE / 64) * (D / 32));
constexpr int FILL_PER_WAVE = 2, FILL_PER_SEAM = 7 * FILL_PER_WAVE, FILL_SEAMS = 4;
__device__ __forceinline__ void p_prep_moe_item(const Ptrs& P, float* scr, int r, int lane) {
    if (r >= MOE_PREP_ITEMS) return;
    constexpr int I_GU = (D / 64) * (DE / 32), I_D = (DE / 64) * (D / 32);
    bf16* WGU = (bf16*)(P.ws + WS_WGU); bf16* WDn = (bf16*)(P.ws + WS_WD);
    const int per_e = 2 * I_GU + I_D; const int e = r / per_e; r -= e * per_e;
    if (r < 2 * I_GU) { const int up = r / I_GU; r -= up * I_GU; const int nblk = DE / 32, kb = r / nblk, nb = r % nblk; const int n0 = 32 * nb;
        const int drow = 256 * (n0 >> 7) + 128 * up + (n0 & 127);
        transpose_item((up ? P.wu : P.wg) + (size_t)e * D * DE, DE, 64 * kb, n0, WGU + ((size_t)e * 1024 + drow) * D + 64 * kb, D, scr, lane); return; }
    r -= 2 * I_GU;
    { const int nblk = D / 32, kb = r / nblk, nb = r % nblk; transpose_item(P.wd + (size_t)e * DE * D, D, 64 * kb, 32 * nb, WDn + ((size_t)e * 1024 + 32 * nb) * DE + 64 * kb, DE, scr, lane); }
}
__device__ __forceinline__ void p_h(const Ptrs& P, int bid, int G, const int TID) {
    const int wave = TID >> 6, lane = TID & 63;
    const float* mod = (const float*)(P.ws + WS_MOD); bf16* Hh = (bf16*)P.out;
    for (int blk = bid; blk < T / 128; blk += G) {
        const int b = (blk * 128) >> 11; const float* shift = mod + b * 6144; const float* scale = shift + 1024;
        f32x4 cm[4], ca[4];
#pragma unroll
        for (int j = 0; j < 4; ++j) { const int col = (64 * j + lane) * 4; cm[j] = *(const f32x4*)(P.g1 + col) * (*(const f32x4*)(scale + col) + 1.0f); ca[j] = *(const f32x4*)(shift + col); }
        const int row0 = blk * 128 + wave * 16;
        f32x4 nx[2][4];
#pragma unroll
        for (int a = 0; a < 2; ++a)
#pragma unroll
            for (int j = 0; j < 4; ++j) nx[a][j] = ((const f32x4*)(P.x + (size_t)(row0 + a) * D) + lane)[64 * j];
        for (int rr = 0; rr < 16; ++rr) { const int row = row0 + rr;
            f32x4 v[4]; float ss = 0.f;
#pragma unroll
            for (int j = 0; j < 4; ++j) { v[j] = nx[0][j]; ss += (v[j].x * v[j].x + v[j].y * v[j].y) + (v[j].z * v[j].z + v[j].w * v[j].w); }
#pragma unroll
            for (int j = 0; j < 4; ++j) nx[0][j] = nx[1][j];
            if (rr + 2 < 16) {
#pragma unroll
                for (int j = 0; j < 4; ++j) nx[1][j] = ((const f32x4*)(P.x + (size_t)(row + 2) * D) + lane)[64 * j]; }
            const float rs = 1.0f / sqrtf(wave_sum_dpp(ss) * (1.0f / D) + EPS);
#pragma unroll
            for (int j = 0; j < 4; ++j) { const int col = (64 * j + lane) * 4;
                const f32x4 o = v[j] * rs * cm[j] + ca[j];
                u32x2 w; w.x = pk2(o.x, o.y); w.y = pk2(o.z, o.w);
                *(u32x2*)(Hh + (size_t)row * D + col) = w; }
        }
    }
}
__device__ __forceinline__ void p_qknorm_vstat(const Ptrs& P, int bid, int G, const int TID) {
    const int wave = TID >> 6, lane = TID & 63;
    bf16* Q = (bf16*)(P.ws + WS_Q); bf16* Kb = (bf16*)(P.ws + WS_K); const bf16* GV = (const bf16*)(P.ws + WS_GV); float* vstat = (float*)(P.ws + WS_VSTAT);
    for (int it = bid * 8 + wave; it < 2 * T; it += G * 8) {
        const int row = it >> 1, isk = it & 1; bf16* p = (isk ? Kb : Q) + (size_t)row * D + lane * 16; const float* g = (isk ? P.kg : P.qg) + (lane & 7) * 16;
        u32x4 w0 = *(u32x4*)p, w1 = *(u32x4*)(p + 8);
        float v[16] = {bflo(w0.x), bfhi(w0.x), bflo(w0.y), bfhi(w0.y), bflo(w0.z), bfhi(w0.z), bflo(w0.w), bfhi(w0.w), bflo(w1.x), bfhi(w1.x), bflo(w1.y), bfhi(w1.y), bflo(w1.z), bfhi(w1.z), bflo(w1.w), bfhi(w1.w)};
        float ss = 0.f;
#pragma unroll
        for (int i = 0; i < 16; ++i) ss += v[i] * v[i];
        ss += __shfl_xor(ss, 1); ss += __shfl_xor(ss, 2); ss += __shfl_xor(ss, 4);
        const float rs = (1.0f / sqrtf(ss * (1.0f / DH) + EPS)) * (isk ? 1.0f : QSCALE);
#pragma unroll
        for (int i = 0; i < 16; ++i) v[i] = v[i] * rs * g[i];
        w0.x = pk2(v[0], v[1]); w0.y = pk2(v[2], v[3]); w0.z = pk2(v[4], v[5]); w0.w = pk2(v[6], v[7]);
        w1.x = pk2(v[8], v[9]); w1.y = pk2(v[10], v[11]); w1.z = pk2(v[12], v[13]); w1.w = pk2(v[14], v[15]);
        *(u32x4*)p = w0; *(u32x4*)(p + 8) = w1;
    }
    for (int row = bid * 8 + wave; row < T; row += G * 8) {
        const bf16* p = GV + (size_t)row * D + lane * 16;
        const u32x4 w0 = *(const u32x4*)p, w1 = *(const u32x4*)(p + 8);
        const unsigned ww[8] = {w0.x, w0.y, w0.z, w0.w, w1.x, w1.y, w1.z, w1.w};
        float ss = 0.f;
#pragma unroll
        for (int i = 0; i < 8; ++i) { const float a = bflo(ww[i]), b = bfhi(ww[i]); ss += a * a + b * b; }
        ss = wave_sum(ss);
        if (lane == 0) vstat[row] = 1.0f / sqrtf(ss * (1.0f / D) + EPS);
    }
}
__device__ __forceinline__ void p_route(const Ptrs& P, unsigned char* lds, int bid, int G, const int TID) {
    float* Wr = (float*)lds;
    int* lcnt = (int*)(Wr + 20 * 1024);
    int* gbase = lcnt + 32;
    int* dec_c = gbase + 32;
    int* dec_lp = dec_c + 128;
    float* dec_w = (float*)(dec_lp + 128);
    const int tid = TID, wave = tid >> 6, lane = tid & 63;
    const float* mod = (const float*)(P.ws + WS_MOD); bf16* H2 = (bf16*)(P.ws + WS_H2);
    int* TOK = (int*)(P.ws + WS_TOK); float* WW = (float*)(P.ws + WS_WW);
    unsigned* cnt = (unsigned*)(P.ws + WS_CTL) + CTL_CNT;
    for (int i = tid; i < 20 * 1024; i += 512) { const int j = i >> 10, k = i & 1023; Wr[i] = (j < 4) ? P.w_rg[k * 4 + j] : P.w_re[(size_t)((j - 4) >> 2) * 4096 + k * 4 + ((j - 4) & 3)]; }
    for (int blk = bid; blk < T / 128; blk += G) {
        if (tid < 32) lcnt[tid] = 0;
        if (wave == 0) { const unsigned* pc = (const unsigned*)(P.ws + WS_CTL) + CW_PAN_X1 + 64 * (blk >> 1); unsigned polls = 0;
            while ((unsigned)__builtin_amdgcn_readfirstlane(__hip_atomic_load(pc, __ATOMIC_RELAXED, __HIP_MEMORY_SCOPE_AGENT)) < 32u) { if (++polls > (1u << 20)) break; __builtin_amdgcn_s_sleep(2); }
            __builtin_amdgcn_fence(__ATOMIC_ACQUIRE, "agent"); asm volatile("s_waitcnt vmcnt(0)" ::: "memory"); }
        __syncthreads();
        const int b = (blk * 128) >> 11;
        const float* shift = mod + b * 6144 + 3072; const float* scale = shift + 1024;
        f32x4 cm[4], ca[4];
#pragma unroll
        for (int j = 0; j < 4; ++j) { const int col = (64 * j + lane) * 4; cm[j] = *(const f32x4*)(P.g2 + col) * (*(const f32x4*)(scale + col) + 1.0f); ca[j] = *(const f32x4*)(shift + col); }
        f32x4 wg[4][4];
#pragma unroll
        for (int j = 0; j < 4; ++j)
#pragma unroll
            for (int q = 0; q < 4; ++q) wg[j][q] = *(const f32x4*)(Wr + q * 1024 + (64 * j + lane) * 4);
        u32x2 nx[2][4];
#pragma unroll
        for (int u = 0; u < 2; ++u) { const u32x2* xr = (const u32x2*)(P.ws + WS_X1 + (size_t)(blk * 128 + wave * 16 + u) * (D * 2)) + lane;
#pragma unroll
            for (int j = 0; j < 4; ++j) nx[u][j] = xr[64 * j]; }
        for (int rr = 0; rr < 16; rr += 2) {
            f32x4 o[2][4]; float ssq[2];
#pragma unroll
            for (int u = 0; u < 2; ++u) { float ss = 0.f;
#pragma unroll
                for (int j = 0; j < 4; ++j) { const u32x2 xw = nx[u][j]; o[u][j] = (f32x4){bflo(xw.x), bfhi(xw.x), bflo(xw.y), bfhi(xw.y)}; ss += (o[u][j].x * o[u][j].x + o[u][j].y * o[u][j].y) + (o[u][j].z * o[u][j].z + o[u][j].w * o[u][j].w); }
                ssq[u] = ss; }
            if (rr + 2 < 16) {
#pragma unroll
                for (int u = 0; u < 2; ++u) { const u32x2* xr = (const u32x2*)(P.ws + WS_X1 + (size_t)(blk * 128 + wave * 16 + rr + 2 + u) * (D * 2)) + lane;
#pragma unroll
                    for (int j = 0; j < 4; ++j) nx[u][j] = xr[64 * j]; } }
            ssq[0] = wave_sum_dpp(ssq[0]); ssq[1] = wave_sum_dpp(ssq[1]);
            f32x4 gp[2];
#pragma unroll
            for (int u = 0; u < 2; ++u) { const int row = blk * 128 + wave * 16 + rr + u; const float rs = 1.0f / sqrtf(ssq[u] * (1.0f / D) + EPS);
                gp[u] = (f32x4){0.f, 0.f, 0.f, 0.f};
#pragma unroll
                for (int j = 0; j < 4; ++j) { const int col = (64 * j + lane) * 4;
                    o[u][j] = o[u][j] * rs * cm[j] + ca[j];
                    u32x2 w; w.x = pk2(o[u][j].x, o[u][j].y); w.y = pk2(o[u][j].z, o[u][j].w);
                    *(u32x2*)(H2 + (size_t)row * D + col) = w;
#pragma unroll
                    for (int q = 0; q < 4; ++q) { const f32x4 wr = wg[j][q]; gp[u][q] += (o[u][j].x * wr.x + o[u][j].y * wr.y) + (o[u][j].z * wr.z + o[u][j].w * wr.w); } } }
#pragma unroll
            for (int q = 0; q < 4; ++q) { gp[0][q] = wave_sum_dpp(gp[0][q]); gp[1][q] = wave_sum_dpp(gp[1][q]); }
            int gtv[2]; float pgv[2]; f32x4 ep[2];
#pragma unroll
            for (int u = 0; u < 2; ++u) { float gl[4];
#pragma unroll
                for (int j = 0; j < 4; ++j) gl[j] = gp[u][j] + P.b_rg[j];
                int gt = 0; float gm = gl[0];
#pragma unroll
                for (int j = 1; j < 4; ++j) if (gl[j] > gm) { gm = gl[j]; gt = j; }
                float den = 0.f;
#pragma unroll
                for (int j = 0; j < 4; ++j) den += __expf(gl[j] - gm);
                gtv[u] = gt; pgv[u] = 1.0f / den;
                ep[u] = (f32x4){0.f, 0.f, 0.f, 0.f};
                const float* We = Wr + (4 + gt * 4) * 1024;
#pragma unroll
                for (int j = 0; j < 4; ++j) { const int col = (64 * j + lane) * 4;
#pragma unroll
                    for (int q = 0; q < 4; ++q) { const f32x4 wr = *(const f32x4*)(We + q * 1024 + col); ep[u][q] += (o[u][j].x * wr.x + o[u][j].y * wr.y) + (o[u][j].z * wr.z + o[u][j].w * wr.w); } } }
#pragma unroll
            for (int q = 0; q < 4; ++q) { ep[0][q] = wave_sum_dpp(ep[0][q]); ep[1][q] = wave_sum_dpp(ep[1][q]); }
#pragma unroll
            for (int u = 0; u < 2; ++u) { const int lrow = wave * 16 + rr + u; const int gt = gtv[u]; float el[4];
#pragma unroll
                for (int e = 0; e < 4; ++e) el[e] = ep[u][e] + P.b_re[gt * 4 + e];
                int i0 = 0; float v0 = el[0];
#pragma unroll
                for (int e = 1; e < 4; ++e) if (el[e] > v0) { v0 = el[e]; i0 = e; }
                int i1 = -1; float v1 = -3.0e38f;
#pragma unroll
                for (int e = 0; e < 4; ++e) if (e != i0 && el[e] > v1) { v1 = el[e]; i1 = e; }
                const float e1 = __expf(v1 - v0); const float p0 = pgv[u] / (1.0f + e1), p1 = pgv[u] * e1 / (1.0f + e1);
                if (lane == 0) { const int ea = i0 < i1 ? i0 : i1, eb = i0 < i1 ? i1 : i0; const int pi = ea == 0 ? eb - 1 : (ea == 1 ? eb + 1 : 5); const int cl = gt * 6 + pi;
                    dec_c[lrow] = cl; dec_w[lrow * 2] = i0 < i1 ? p0 : p1; dec_w[lrow * 2 + 1] = i0 < i1 ? p1 : p0;
                    dec_lp[lrow] = atomicAdd(&lcnt[cl], 1); } }
        }
        __syncthreads();
        int t2 = tid; OPAQUE(t2);
        if (t2 < NCLS) gbase[t2] = (int)atomicAdd(&cnt[t2], (unsigned)lcnt[t2]);
        __syncthreads();
        if (t2 < 128) { const int cl = dec_c[t2], pos = gbase[cl] + dec_lp[t2]; const int tok = blk * 128 + t2;
            TOK[(size_t)cl * T + pos] = tok; WW[((size_t)cl * T + pos) * 2] = dec_w[t2 * 2]; WW[((size_t)cl * T + pos) * 2 + 1] = dec_w[t2 * 2 + 1]; }
        __syncthreads();
    }
}
struct Args { Ptrs p; int ph_lo, ph_hi; };
constexpr int N_PHASES = 9;
__global__ void __launch_bounds__(512, 2) mk_fwd(Args args) {
    extern __shared__ __attribute__((aligned(16))) unsigned char lds[];
    const Ptrs& P = args.p;
    LAS unsigned char* L = (LAS unsigned char*)lds;
    volatile LAS unsigned* MISC = (volatile LAS unsigned*)(L + LDS_MISC);
    LAS int* tb = (LAS int*)(L + LDS_MISC + 256);
    const int wid_s = __builtin_amdgcn_readfirstlane((int)threadIdx.x >> 6);
#define TIDX() ((wid_s << 6) | lane_id_fresh())
    const int G = gridDim.x, bid = blockIdx.x;
    const int vcu = (G % 8 == 0) ? (bid % 8) * (G / 8) + bid / 8 : bid;
    unsigned char* ws = P.ws;
    for (int u = TIDX(); u < (LDS_BYTES - LDS_MISC) / 4; u += 512) ((LAS unsigned*)(L + LDS_MISC))[u] = 0u;
    __syncthreads();
    XcdBarrier bar = xcd_barrier_post((unsigned*)(ws + WS_CTL) + CW_BAR, MISC + 8, wid_s == 0);
    const int lo = args.ph_lo, hi = args.ph_hi;
#define IN(k) (lo <= (k) && (k) < hi)
#define SEAM(k) do { if (IN(k) && IN((k) + 1)) xcd_barrier(bar, NoFill{}); } while (0)
#define SEAMF(k) do { if (IN(k) && IN((k) + 1)) xcd_barrier(bar, [&]() { \
        _Pragma("unroll 1") for (int k_ = 0; k_ < FILL_PER_WAVE; ++k_) { const int slot_ = (k) * FILL_PER_SEAM + (wid_s - 1) * FILL_PER_WAVE + k_; \
            p_prep_moe_item(P, (float*)lds + wid_s * (64 * 33), slot_ * G + vcu, lane_id_fresh()); } }); } while (0)
    bf16* Hh = (bf16*)P.out; bf16* GU = (bf16*)((unsigned char*)P.out + 64 * MiB); bf16* SG = Hh;
    bf16* GV = (bf16*)(ws + WS_GV); bf16* Q = (bf16*)(ws + WS_Q); bf16* Kb = (bf16*)(ws + WS_K); bf16* V = (bf16*)(ws + WS_V); bf16* SA = (bf16*)(ws + WS_SA); bf16* SB = (bf16*)(ws + WS_SB);
    bf16* MG = (bf16*)(ws + WS_MG); bf16* H2 = (bf16*)(ws + WS_H2); bf16* ACT = (bf16*)(ws + WS_ACT);
    const float* mod = (const float*)(ws + WS_MOD); const unsigned* cnt = (const unsigned*)(ws + WS_CTL) + CTL_CNT; unsigned* ctlw = (unsigned*)(ws + WS_CTL);

    if (IN(0)) { p_mod(P, lds, bid, G, TIDX()); __syncthreads(); p_prep(P, lds, bid, G, TIDX());
        if (hi - lo < N_PHASES) { for (int sl = wid_s; sl * G + vcu < MOE_PREP_ITEMS; sl += 8) p_prep_moe_item(P, (float*)lds + wid_s * (64 * 33), sl * G + vcu, lane_id_fresh()); } } SEAMF(0);
    if (IN(1)) { p_h(P, bid, G, TIDX()); } SEAMF(1);
    if (IN(2)) {
        pg8::DenseOrder S{(const char*)Hh, (const char*)Hh, (const char*)(ws + WS_WIN), (size_t)256 * D * 2, (size_t)256 * D * 2, T / 256, INW / 256, (T / 256) * (INW / 256), G, bid, nullptr, 0u, nullptr, nullptr};
        EpiInProj E{GU, GV, Q, Kb, V, SA, SB, P.qg, P.kg, (float*)(ws + WS_VSTAT), (LAS float*)(L + LDS_EPI)};
        pg8::gemm_phase<EpiInProj, pg8::DenseOrder, false, false>(L + LDS_STAGE, D / 64, D / 64, D, D, S, E, TIDX());
    } SEAMF(2);
    if (IN(3)) { sgu::sgu_phase(GU, GV, (const float*)(ws + WS_VSTAT), P.sgn, (const bf16*)(ws + WS_SW), P.sgu_b, SG, lds, vcu, G, TIDX()); att::attn_phase(Kb, V, Q, P.qg, P.kg, lds, vcu, G, TIDX()); } SEAMF(3);
    if (IN(3) && IN(4)) { for (int sl = FILL_SEAMS * FILL_PER_SEAM + wid_s; sl * G + vcu < MOE_PREP_ITEMS; sl += 8) p_prep_moe_item(P, (float*)lds + wid_s * (64 * 33), sl * G + vcu, lane_id_fresh()); __syncthreads(); }
    if (IN(4)) {
        pg8::DenseOrder S{(const char*)SG, (const char*)Q - (size_t)16 * 128, (const char*)(ws + WS_WAB), (size_t)256 * D * 2, (size_t)256 * 2048 * 2, T / 256, 4, (T / 256) * 4, G, bid, nullptr, 0u, ctlw + CW_PAN_MG, nullptr};
        EpiProjAB E{SA, SB, MG};
        pg8::gemm_phase<EpiProjAB, pg8::DenseOrder, false, true>(L + LDS_STAGE, 32, 16, D, 2048, S, E, TIDX());
    }
    if (IN(5)) {
        pg8::DenseOrder S{(const char*)MG, (const char*)MG, (const char*)(ws + WS_WO), (size_t)256 * D * 2, (size_t)256 * D * 2, T / 256, 4, (T / 256) * 4, G, bid, ctlw + CW_PAN_MG, 32u, ctlw + CW_PAN_X1, ctlw + CW_BAR + XB_TMO};
        EpiOut E{P.x, mod, (bf16*)(ws + WS_X1)};
        pg8::gemm_phase<EpiOut, pg8::DenseOrder, false, false>(L + LDS_STAGE, D / 64, D / 64, D, D, S, E, TIDX());
    }
    if (IN(6)) { p_route(P, lds, bid, G, TIDX()); } SEAM(6);
    if (IN(7) || IN(8)) {
        if (TIDX() == 0) { int base = 0; for (int c = 0; c < NCLS; ++c) { tb[c] = base; base += ((int)cnt[c] + 255) >> 8; } tb[NCLS] = base; }
        __syncthreads();
    }
    if (IN(7)) {
        pg8::MoeOrder1 S{tb, cnt, (const char*)H2, (const char*)(ws + WS_WGU), (const int*)(ws + WS_TOK), G, vcu, (unsigned*)(ws + WS_CTL) + CW_TILE};
        EpiMoe1 E{ACT, (const float*)(ws + WS_WW)};
        pg8::gemm_phase<EpiMoe1, pg8::MoeOrder1, true, false>(L + LDS_STAGE, D / 64, D / 64, D, D, S, E, TIDX());
    }
    if (IN(8)) {
        pg8::MoeOrder2 S{tb, cnt, (const char*)ACT, (const char*)(ws + WS_WD), (const int*)(ws + WS_TOK), G, G - 1 - vcu  , (unsigned*)(ws + WS_CTL) + CW_TILE, (unsigned*)(ws + WS_CTL) + CW_BAR + XB_TMO};
        EpiMoe2 E{P.out, mod, (const bf16*)(ws + WS_X1)};
        pg8::gemm_phase<EpiMoe2, pg8::MoeOrder2, false, false, true>(L + LDS_STAGE, 16, 8, 1024, DE, S, E, TIDX());
    }
#undef IN
#undef SEAM
#undef SEAMF
}

#ifndef MK_PER_PHASE
#define MK_PER_PHASE 0
#endif
extern "C" void kernel_launch(void* const* d_in, const int* in_sizes, int n_in, void* d_out, int out_size, void* d_ws, size_t ws_size, hipStream_t stream) {
    static int grid = 0;
    if (grid == 0) {
        if (n_in != 22 || in_sizes[0] != T * D || out_size != T * D || ws_size < WS_END) { fprintf(stderr, "kernel_launch: shape/ws mismatch n_in %d in0 %d out %d ws %zu\n", n_in, n_in > 0 ? in_sizes[0] : -1, out_size, ws_size); grid = -1; return; }
        int dev = 0, cus = 0;
        if (hipGetDevice(&dev) != hipSuccess || hipDeviceGetAttribute(&cus, hipDeviceAttributeMultiprocessorCount, dev) != hipSuccess) { grid = -1; return; }
        if (hipFuncSetAttribute((const void*)mk_fwd, hipFuncAttributeMaxDynamicSharedMemorySize, LDS_BYTES) != hipSuccess) { fprintf(stderr, "kernel_launch: hipFuncSetAttribute failed\n"); grid = -1; return; }
        grid = cus;
    }
    if (grid < 0) return;
    (void)hipMemsetAsync((char*)d_ws + WS_CTL, 0, 1 * MiB, stream);
    Args a{};
    const float** pp = (const float**)&a.p;
    for (int i = 0; i < 22; ++i) pp[i] = (const float*)d_in[i];
    a.p.out = (float*)d_out; a.p.ws = (unsigned char*)d_ws;
#if MK_PER_PHASE
    for (int k = 0; k < N_PHASES; ++k) { a.ph_lo = k; a.ph_hi = k + 1; hipLaunchKernelGGL(mk_fwd, dim3(grid), dim3(512), LDS_BYTES, stream, a); }
#else
    a.ph_lo = 0; a.ph_hi = N_PHASES;
    hipLaunchKernelGGL(mk_fwd, dim3(grid), dim3(512), LDS_BYTES, stream, a);
#endif
}
```

```cpp
#include <hip/hip_runtime.h>
#include <cstdio>
#include <cstdint>

#define LAS __attribute__((address_space(3)))
typedef unsigned short bf16;
typedef float f32x4 __attribute__((ext_vector_type(4)));
typedef unsigned u32x4 __attribute__((ext_vector_type(4)));
typedef float f32x2 __attribute__((ext_vector_type(2)));
typedef unsigned u32x2 __attribute__((ext_vector_type(2)));
typedef short bf16x8 __attribute__((ext_vector_type(8)));

constexpr int NB = 16, S = 2048, D = 1024, T = NB * S, INW = 7168, NH = 8, DH = 128, NE = 16, DE = 512, NCLS = 24;
constexpr float EPS = 1e-6f;
constexpr float LOG2E = 1.4426950408889634f;
constexpr float QSCALE = 0.08838834764831845f * LOG2E;

constexpr size_t MiB = 1u << 20;
constexpr size_t WS_CTL = 0;
constexpr size_t WS_WIN = 2 * MiB;
constexpr size_t WS_WAB = 16 * MiB;
constexpr size_t WS_WO = 20 * MiB;
constexpr size_t WS_WGU = 22 * MiB;
constexpr size_t WS_WD = 54 * MiB;
constexpr size_t WS_MOD = 70 * MiB;
constexpr size_t WS_VSTAT = 71 * MiB;
constexpr size_t WS_SW = 71 * MiB + 512 * 1024;
constexpr size_t WS_TOK = 72 * MiB;
constexpr size_t WS_WW = 464 * MiB;
constexpr size_t WS_GV = 80 * MiB;
constexpr size_t WS_Q = 144 * MiB;
constexpr size_t WS_K = 208 * MiB;
constexpr size_t WS_V = 272 * MiB;
constexpr size_t WS_SA = 336 * MiB;
constexpr size_t WS_SB = 400 * MiB;
constexpr size_t WS_END = 512 * MiB;
constexpr size_t WS_ACT = 336 * MiB;
constexpr size_t WS_MG = WS_K, WS_H2 = WS_Q;
constexpr size_t WS_X1 = WS_GV;
constexpr int CTL_CNT = 1024;
constexpr int CW_BAR = 4096;
constexpr int CW_PAN_MG = 32768, CW_PAN_X1 = 49152;
constexpr int CW_TILE = 16384;

constexpr int LDS_STAGE = 0;
constexpr int LDS_EPI = 131072;
constexpr int LDS_MISC = 139264;
constexpr int LDS_BYTES = 147456;

__device__ __forceinline__ unsigned f2bf(float f) { unsigned u = __builtin_bit_cast(unsigned, f); return (u + 0x7fffu + ((u >> 16) & 1u)) >> 16; }
__device__ __forceinline__ unsigned pk2(float lo, float hi) { unsigned r; asm("v_cvt_pk_bf16_f32 %0, %1, %2" : "=v"(r) : "v"(lo), "v"(hi)); return r; }
__device__ __forceinline__ float bf2f(unsigned short b) { return __builtin_bit_cast(float, ((unsigned)b) << 16); }
__device__ __forceinline__ float bflo(unsigned w) { return __builtin_bit_cast(float, w << 16); }
__device__ __forceinline__ float bfhi(unsigned w) { return __builtin_bit_cast(float, w & 0xffff0000u); }
__device__ __forceinline__ unsigned cvt_pk_bf16(float lo, float hi) { unsigned r; asm volatile("v_cvt_pk_bf16_f32 %0, %1, %2" : "=v"(r) : "v"(lo), "v"(hi)); return r; }
__device__ __forceinline__ float wave_sum(float v) {
#pragma unroll
    for (int o = 1; o < 64; o <<= 1) v += __shfl_xor(v, o);
    return v;
}
__device__ __forceinline__ float row16_sum(float x) {
    x += __builtin_bit_cast(float, __builtin_amdgcn_update_dpp(0, __builtin_bit_cast(int, x), 0xB1, 0xF, 0xF, true));
    x += __builtin_bit_cast(float, __builtin_amdgcn_update_dpp(0, __builtin_bit_cast(int, x), 0x4E, 0xF, 0xF, true));
    x += __builtin_bit_cast(float, __builtin_amdgcn_update_dpp(0, __builtin_bit_cast(int, x), 0x141, 0xF, 0xF, true));
    x += __builtin_bit_cast(float, __builtin_amdgcn_update_dpp(0, __builtin_bit_cast(int, x), 0x140, 0xF, 0xF, true));
    return x;
}
__device__ __forceinline__ float rows_sum(float x) {
    { unsigned a = __builtin_bit_cast(unsigned, x), b = a; asm volatile("" : "+v"(b));
      const auto r = __builtin_amdgcn_permlane16_swap(a, b, false, false); x = __builtin_bit_cast(float, (unsigned)r[0]) + __builtin_bit_cast(float, (unsigned)r[1]); }
    { unsigned a = __builtin_bit_cast(unsigned, x), b = a; asm volatile("" : "+v"(b));
      const auto r = __builtin_amdgcn_permlane32_swap(a, b, false, false); x = __builtin_bit_cast(float, (unsigned)r[0]) + __builtin_bit_cast(float, (unsigned)r[1]); }
    return x;
}
__device__ __forceinline__ float wave_sum_dpp(float x) {
    x = row16_sum(x);
    { unsigned a = __builtin_bit_cast(unsigned, x), b = a; asm volatile("" : "+v"(b));
      const auto r = __builtin_amdgcn_permlane16_swap(a, b, false, false); x = __builtin_bit_cast(float, (unsigned)r[0]) + __builtin_bit_cast(float, (unsigned)r[1]); }
    { unsigned a = __builtin_bit_cast(unsigned, x), b = a; asm volatile("" : "+v"(b));
      const auto r = __builtin_amdgcn_permlane32_swap(a, b, false, false); x = __builtin_bit_cast(float, (unsigned)r[0]) + __builtin_bit_cast(float, (unsigned)r[1]); }
    return x;
}
__device__ __forceinline__ float fold32(float a, float b) { const auto r = __builtin_amdgcn_permlane32_swap(__builtin_bit_cast(unsigned, a), __builtin_bit_cast(unsigned, b), false, false);
    return __builtin_bit_cast(float, (unsigned)r[0]) + __builtin_bit_cast(float, (unsigned)r[1]); }
__device__ __forceinline__ float fold16(float a, float b) { const auto r = __builtin_amdgcn_permlane16_swap(__builtin_bit_cast(unsigned, a), __builtin_bit_cast(unsigned, b), false, false);
    return __builtin_bit_cast(float, (unsigned)r[0]) + __builtin_bit_cast(float, (unsigned)r[1]); }
__device__ __forceinline__ float pick_lane(float x, int l) { return __builtin_bit_cast(float, __builtin_amdgcn_readlane(__builtin_bit_cast(int, x), l)); }
__device__ __forceinline__ void wave_sum8(f32x4& a, f32x4& b) {
    const float p01 = fold32(a.x, a.y), p23 = fold32(a.z, a.w), p45 = fold32(b.x, b.y), p67 = fold32(b.z, b.w);
    const float q0 = row16_sum(fold16(p01, p23)), q1 = row16_sum(fold16(p45, p67));
    a.x = pick_lane(q0, 0); a.z = pick_lane(q0, 16); a.y = pick_lane(q0, 32); a.w = pick_lane(q0, 48);
    b.x = pick_lane(q1, 0); b.z = pick_lane(q1, 16); b.y = pick_lane(q1, 32); b.w = pick_lane(q1, 48);
}
__device__ __forceinline__ void wave_sum2(float& a, float& b) {
    float x = row16_sum(fold32(a, b));
    { unsigned c = __builtin_bit_cast(unsigned, x), d = c; asm volatile("" : "+v"(d));
      const auto r = __builtin_amdgcn_permlane16_swap(c, d, false, false); x = __builtin_bit_cast(float, (unsigned)r[0]) + __builtin_bit_cast(float, (unsigned)r[1]); }
    a = pick_lane(x, 0); b = pick_lane(x, 32);
}
__device__ __forceinline__ void st16_wt(void* base, unsigned byte_off, u32x4 v) {
    const __amdgpu_buffer_rsrc_t r = __builtin_amdgcn_make_buffer_rsrc(base, 0, 0x7fffffff, 0x00020000);
    __builtin_amdgcn_raw_buffer_store_b128(v, r, (int)byte_off, 0, 16);
}
__device__ __forceinline__ void st8_wt(void* base, unsigned byte_off, u32x2 v) {
    const __amdgpu_buffer_rsrc_t r = __builtin_amdgcn_make_buffer_rsrc(base, 0, 0x7fffffff, 0x00020000);
    __builtin_amdgcn_raw_buffer_store_b64(v, r, (int)byte_off, 0, 16);
}
__device__ __forceinline__ int lane_id_fresh() { int l; asm volatile("v_mbcnt_lo_u32_b32 %0, -1, 0\n\tv_mbcnt_hi_u32_b32 %0, -1, %0" : "=v"(l)); return l; }
__device__ __forceinline__ float fast_rcp(float x) { return __builtin_amdgcn_rcpf(x); }
__device__ __forceinline__ float gelu_tanh(float x) {
    const float u = x * (0.7978845608028654f + 0.035677408136300125f * x * x);
    return x * fast_rcp(1.0f + __builtin_amdgcn_exp2f(-2.0f * LOG2E * u));
}
__device__ __forceinline__ float sigmoidf_(float x) { return fast_rcp(1.0f + __builtin_amdgcn_exp2f(-LOG2E * x)); }
__device__ __forceinline__ f32x4 exp2_4(f32x4 t) { f32x4 e; e.x = __builtin_amdgcn_exp2f(t.x); e.y = __builtin_amdgcn_exp2f(t.y); e.z = __builtin_amdgcn_exp2f(t.z); e.w = __builtin_amdgcn_exp2f(t.w); return e; }
__device__ __forceinline__ f32x4 rcp_4(f32x4 t) { f32x4 e; e.x = fast_rcp(t.x); e.y = fast_rcp(t.y); e.z = fast_rcp(t.z); e.w = fast_rcp(t.w); return e; }
__device__ __forceinline__ f32x4 gelu4(f32x4 x) {
    const f32x4 t = x * (x * x * (-2.0f * LOG2E * 0.035677408136300125f) + (-2.0f * LOG2E * 0.7978845608028654f));
    return x * rcp_4(exp2_4(t) + 1.0f);
}
__device__ __forceinline__ f32x4 sigmoid4(f32x4 x) { return rcp_4(exp2_4(x * (-LOG2E)) + 1.0f); }
__device__ __forceinline__ float siluf_(float x) { return x * fast_rcp(1.0f + __builtin_amdgcn_exp2f(-LOG2E * x)); }

__device__ __forceinline__ unsigned dpp_swap1(unsigned x) { return (unsigned)__builtin_amdgcn_update_dpp(0, (int)x, 0xB1, 0xF, 0xF, false); }
template <bool NT> __device__ __forceinline__ void st_lines(char* p, unsigned ld, u32x4 w0, u32x4 w1, bool odd) {
    const u32x4 x = odd ? w0 : w1; u32x4 y; y.x = dpp_swap1(x.x); y.y = dpp_swap1(x.y); y.z = dpp_swap1(x.z); y.w = dpp_swap1(x.w);
    const u32x4 d1 = odd ? y : w0, d2 = odd ? w1 : y;
    if constexpr (NT) { __builtin_nontemporal_store(d1, (u32x4*)p); __builtin_nontemporal_store(d2, (u32x4*)(p + ld)); }
    else { *(u32x4*)p = d1; *(u32x4*)(p + ld) = d2; }
}
__device__ __forceinline__ void st_lines_wt(void* base, unsigned off, unsigned ld, u32x4 w0, u32x4 w1, bool odd) {
    const u32x4 x = odd ? w0 : w1; u32x4 y; y.x = dpp_swap1(x.x); y.y = dpp_swap1(x.y); y.z = dpp_swap1(x.z); y.w = dpp_swap1(x.w);
    st16_wt(base, off, odd ? y : w0); st16_wt(base, off + ld, odd ? w1 : y);
}
__device__ __forceinline__ void st16_ntwt(void* base, unsigned byte_off, u32x4 v) {
    const __amdgpu_buffer_rsrc_t r = __builtin_amdgcn_make_buffer_rsrc(base, 0, 0x7fffffff, 0x00020000);
    __builtin_amdgcn_raw_buffer_store_b128(v, r, (int)byte_off, 0, 18);
}
__device__ __forceinline__ void st_lines_ntwt(void* base, unsigned off, unsigned ld, u32x4 w0, u32x4 w1, bool odd) {
    const u32x4 x = odd ? w0 : w1; u32x4 y; y.x = dpp_swap1(x.x); y.y = dpp_swap1(x.y); y.z = dpp_swap1(x.z); y.w = dpp_swap1(x.w);
    st16_ntwt(base, off, odd ? y : w0); st16_ntwt(base, off + ld, odd ? w1 : y);
}
__device__ __forceinline__ void ld_lines_fix(u32x4 l1, u32x4 l2, bool odd, u32x4& w0, u32x4& w1) {
    const u32x4 x = odd ? l1 : l2; u32x4 y; y.x = dpp_swap1(x.x); y.y = dpp_swap1(x.y); y.z = dpp_swap1(x.z); y.w = dpp_swap1(x.w);
    w0 = odd ? y : l1; w1 = odd ? l2 : y;
}
__device__ __forceinline__ unsigned q255x4(f32x4 s, float lo) { unsigned w = 0; const f32x4 t = s * 255.0f;
    w = __builtin_amdgcn_cvt_pk_u8_f32(fmaxf(t.x, lo), 0, w); w = __builtin_amdgcn_cvt_pk_u8_f32(fmaxf(t.y, lo), 1, w);
    w = __builtin_amdgcn_cvt_pk_u8_f32(fmaxf(t.z, lo), 2, w); w = __builtin_amdgcn_cvt_pk_u8_f32(fmaxf(t.w, lo), 3, w); return w; }
__device__ __forceinline__ f32x4 ub4(unsigned w) { return (f32x4){(float)(w & 0xffu), (float)((w >> 8) & 0xffu), (float)((w >> 16) & 0xffu), (float)(w >> 24)}; }
namespace pg8 {
constexpr int BM = 256, BK = 64, HALF = 128, HTB = HALF * BK * 2, STAGE_BYTES = 8 * HTB, NXCD = 8, WGM = 3;
__host__ __device__ __forceinline__ int lds_byte(int r, int c) { const int st = (r >> 4) * 2 + (c >> 5), rr = r & 15, cc = c & 31, ob = rr * 64 + cc * 2; return st * 1024 + (ob ^ (((ob >> 9) & 1) << 5)); }
__host__ __device__ __forceinline__ void stage_rc(int b, int& R, int& C) { const int st = b / 1024, sb = b % 1024, swz = sb ^ (((sb >> 9) & 1) << 5); R = (st >> 1) * 16 + swz / 64; C = (st & 1) * 32 + (swz % 64) / 2; }
__host__ __device__ __forceinline__ int perm32(int rho) { const int n = rho >> 4, i = rho & 15; return 8 * (i >> 2) + 4 * n + (i & 3); }

struct Unit { const char* a; const char* a2; const char* b; const char* b2; const int* ridx; int nrows; int pm, pn, e, lt; };

template <class Epi, class Sched, bool GATHER, bool MIDK, bool BSPLIT = false>
__device__ __forceinline__ void gemm_phase(LAS unsigned char* lds, const int nt, const int ksplit, const int lda, const int ldb, const Sched& S, const Epi& E, const int TID) {
    const int tid = TID, wid = __builtin_amdgcn_readfirstlane(tid >> 6), lane = tid & 63, wr = wid >> 2, wc = wid & 3, fr = lane & 15, fq = lane >> 4;
    int RA[2], CA[2]; unsigned voffB[2];
#pragma unroll
    for (int i = 0; i < 2; ++i) { int R, C; stage_rc(tid * 16 + i * 8192, R, C); RA[i] = R; CA[i] = C; const int Rb = Epi::PERM == 2 ? (64 * (R >> 5) + perm32(R & 31)) : Epi::PERM == 1 ? ((R & ~31) + perm32(R & 31)) : R; voffB[i] = (unsigned)(Rb * ldb + C) * 2u; }
    unsigned cG[2][2], nG[2][2];
    const size_t kstep = (size_t)(BK * 2);
    const size_t hstepB = (size_t)(Epi::PERM == 2 ? 32 : HALF) * ldb * 2;
    const unsigned ldsw = (unsigned)wid * 1024u;
    const int aoff = lds_byte(wr * 64 + fr, fq * 8), boff = lds_byte(wc * 32 + fr, fq * 8);
#define PG8_SETOFF(G, u) do { _Pragma("unroll") for (int _h = 0; _h < 2; ++_h) _Pragma("unroll") for (int _i = 0; _i < 2; ++_i) { \
        int _row = _h * HALF + RA[_i]; if constexpr (GATHER) { _row = (_row < (u).nrows) ? (u).ridx[_row] : 0; } \
        G[_h][_i] = (unsigned)(_row * lda + CA[_i]) * 2u; } } while (0)
#define PG8_AP(u, t) (((MIDK && (t) >= ksplit) ? (u).a2 : (u).a) + (size_t)(t) * kstep)
#define PG8_BP(u, t) (((BSPLIT && (t) >= ksplit) ? (u).b2 : (u).b) + (size_t)(t) * kstep)
#define PG8_SA(b, h) (((b) * 2 + (h)) * HTB)
#define PG8_SB(b, h) ((4 + (b) * 2 + (h)) * HTB)
#define PG8_ST2(bufoff, p0, p1) do { __builtin_amdgcn_global_load_lds((const unsigned*)(p0), (LAS unsigned*)(lds + (bufoff) + ldsw), 16, 0, 0); \
        __builtin_amdgcn_global_load_lds((const unsigned*)(p1), (LAS unsigned*)(lds + (bufoff) + ldsw + 8192), 16, 0, 0); } while (0)
#define PG8_STAGE_B(bufoff, gb) PG8_ST2(bufoff, (gb) + voffB[0], (gb) + voffB[1])
#define PG8_STAGE_AC(bufoff, ga, h) PG8_ST2(bufoff, (ga) + cG[h][0], (ga) + cG[h][1])
#define PG8_STAGE_AS(bufoff, ga, h) PG8_ST2(bufoff, (ga) + (last ? nG[h][0] : cG[h][0]), (ga) + (last ? nG[h][1] : cG[h][1]))
#define PG8_LDA(dst, b, h) do { _Pragma("unroll") for (int m = 0; m < 4; ++m) _Pragma("unroll") for (int k = 0; k < 2; ++k) dst[m][k] = *(const LAS bf16x8*)(lds + PG8_SA(b, h) + aoff + m * 2048 + k * 1024); } while (0)
#define PG8_LDB(dst, b, h) do { _Pragma("unroll") for (int n = 0; n < 2; ++n) _Pragma("unroll") for (int k = 0; k < 2; ++k) dst[n][k] = *(const LAS bf16x8*)(lds + PG8_SB(b, h) + boff + n * 2048 + k * 1024); } while (0)
#define PG8_MMA(ai, bj, At, Bt) do { __builtin_amdgcn_s_setprio(1); _Pragma("unroll") for (int m = 0; m < 4; ++m) _Pragma("unroll") for (int n = 0; n < 2; ++n) _Pragma("unroll") for (int k = 0; k < 2; ++k) \
        acc[ai][bj][m][n] = __builtin_amdgcn_mfma_f32_16x16x32_bf16(Bt[n][k], At[m][k], acc[ai][bj][m][n], 0, 0, 0); __builtin_amdgcn_s_setprio(0); } while (0)
#define PG8_WAIT_V(n) asm volatile("s_waitcnt vmcnt(" #n ")" ::: "memory")
#define PG8_WAIT_L(n) asm volatile("s_waitcnt lgkmcnt(" #n ")" ::: "memory")
#define PG8_BAR __builtin_amdgcn_s_barrier()
#define PG8_SCHED __builtin_amdgcn_sched_barrier(0)
    Unit cur, nxt; int ui = 0;
    if (!S.next(0, cur)) return;
    f32x4 acc[2][2][4][2];
#pragma unroll
    for (int a = 0; a < 2; ++a)
#pragma unroll
        for (int b = 0; b < 2; ++b)
#pragma unroll
            for (int m = 0; m < 4; ++m)
#pragma unroll
                for (int n = 0; n < 2; ++n) acc[a][b][m][n] = (f32x4){0.f, 0.f, 0.f, 0.f};
    bf16x8 At[4][2], B0[2][2], B1[2][2];
    S.a_ready(cur, wid, lane);
    PG8_SETOFF(cG, cur);
    {
        const char* a0 = PG8_AP(cur, 0); const char* a1 = PG8_AP(cur, 1); const char* cB = PG8_BP(cur, 0);
        PG8_STAGE_B(PG8_SB(0, 0), cB); PG8_STAGE_B(PG8_SB(0, 1), cB + hstepB); PG8_STAGE_AC(PG8_SA(0, 0), a0, 0); PG8_STAGE_AC(PG8_SA(0, 1), a0, 1);
        if (wr == 1) PG8_BAR;
        PG8_WAIT_V(2); PG8_BAR;
        PG8_STAGE_B(PG8_SB(1, 0), cB + kstep); PG8_STAGE_AC(PG8_SA(1, 0), a1, 0); PG8_STAGE_B(PG8_SB(1, 1), cB + hstepB + kstep);
        PG8_WAIT_V(6); PG8_BAR;
    }
    for (;;) {
        const bool has_next = S.next(ui + 1, nxt);
        if (!has_next) nxt = cur;
        if constexpr (GATHER) { PG8_SETOFF(nG, nxt); }
        for (int t = 0; t < nt; t += 2) {
            const bool last = (t == nt - 2);
            if (last && has_next) S.a_ready(nxt, wid, lane);
            if constexpr (MIDK) { if (t == ksplit) E.mid(acc, cur, wr, wc, fr, fq); }
            const char* a1 = PG8_AP(cur, t + 1);
            const char* a2 = last ? PG8_AP(nxt, 0) : PG8_AP(cur, t + 2); const char* b2 = last ? PG8_BP(nxt, 0) : PG8_BP(cur, t + 2);
            const char* a3 = last ? PG8_AP(nxt, 1) : PG8_AP(cur, t + 3); const char* b3 = b2 + kstep;
            PG8_LDB(B0, 0, 0); PG8_LDB(B1, 0, 1); PG8_SCHED; PG8_LDA(At, 0, 0); PG8_STAGE_AC(PG8_SA(1, 1), a1, 1);
            PG8_WAIT_V(8); PG8_WAIT_L(0); PG8_BAR; PG8_MMA(0, 0, At, B0); PG8_MMA(0, 1, At, B1); PG8_BAR; PG8_SCHED;
            PG8_LDA(At, 0, 1); PG8_STAGE_B(PG8_SB(0, 0), b2); PG8_STAGE_B(PG8_SB(0, 1), b2 + hstepB);
            if constexpr (GATHER) { PG8_STAGE_AS(PG8_SA(0, 0), a2, 0); } else { PG8_STAGE_AC(PG8_SA(0, 0), a2, 0); }
            PG8_WAIT_V(8); PG8_WAIT_L(0); PG8_BAR; PG8_MMA(1, 0, At, B0); PG8_MMA(1, 1, At, B1); PG8_BAR; PG8_SCHED;
            PG8_LDB(B0, 1, 0); PG8_LDB(B1, 1, 1); PG8_SCHED; PG8_LDA(At, 1, 0);
            if constexpr (GATHER) { PG8_STAGE_AS(PG8_SA(0, 1), a2, 1); } else { PG8_STAGE_AC(PG8_SA(0, 1), a2, 1); }
            PG8_WAIT_V(8); PG8_WAIT_L(0); PG8_BAR; PG8_MMA(0, 0, At, B0); PG8_MMA(0, 1, At, B1); PG8_BAR; PG8_SCHED;
            PG8_LDA(At, 1, 1); PG8_STAGE_B(PG8_SB(1, 0), b3); PG8_STAGE_B(PG8_SB(1, 1), b3 + hstepB);
            if constexpr (GATHER) { PG8_STAGE_AS(PG8_SA(1, 0), a3, 0); } else { PG8_STAGE_AC(PG8_SA(1, 0), a3, 0); }
            PG8_WAIT_V(8); PG8_WAIT_L(0); PG8_BAR; PG8_MMA(1, 0, At, B0); PG8_MMA(1, 1, At, B1); PG8_BAR; PG8_SCHED;
        }
        if (wr == 0) PG8_BAR;
        E(acc, cur, wr, wc, fr, fq);
        S.done(cur, lane);
        if (!has_next) break;
#pragma unroll
        for (int a = 0; a < 2; ++a)
#pragma unroll
            for (int b = 0; b < 2; ++b)
#pragma unroll
                for (int m = 0; m < 4; ++m)
#pragma unroll
                    for (int n = 0; n < 2; ++n) acc[a][b][m][n] = (f32x4){0.f, 0.f, 0.f, 0.f};
        cur = nxt; ++ui;
        if constexpr (GATHER) {
#pragma unroll
            for (int h = 0; h < 2; ++h)
#pragma unroll
                for (int i = 0; i < 2; ++i) cG[h][i] = nG[h][i]; }
        if (wr == 1) PG8_BAR;
    }
    PG8_WAIT_V(0);
    PG8_BAR;
#undef PG8_SETOFF
#undef PG8_AP
#undef PG8_BP
#undef PG8_SA
#undef PG8_SB
#undef PG8_ST2
#undef PG8_STAGE_B
#undef PG8_STAGE_AC
#undef PG8_STAGE_AS
#undef PG8_LDA
#undef PG8_LDB
#undef PG8_MMA
#undef PG8_WAIT_V
#undef PG8_WAIT_L
#undef PG8_BAR
#undef PG8_SCHED
}

struct DenseOrder {
    const char* A; const char* A2; const char* B; size_t tstepA, tstepB; int nM, nN, nwg, G, c;
    unsigned* wait_cnt; unsigned need; unsigned* pub_cnt; unsigned* tmo; int nrev = 0;
    __device__ bool next(int i, Unit& u) const {
        if (nrev > 0 && i >= nrev) return false;
        const long L = (long)(nrev > 0 ? nrev - 1 - i : i) * G + c; if (L >= nwg) return false;
        int wgid = (int)L; { const int q = nwg / NXCD, r = nwg % NXCD, xcd = wgid % NXCD, off = wgid / NXCD; wgid = (xcd < r ? xcd * (q + 1) : r * (q + 1) + (xcd - r) * q) + off; }
        const int nig = WGM * nN, gid = wgid / nig, fm = gid * WGM, gsz = (nM - fm) < WGM ? (nM - fm) : WGM;
        u.pm = fm + ((wgid % nig) % gsz); u.pn = (wgid % nig) / gsz;
        u.a = A + (size_t)u.pm * tstepA; u.a2 = A2 + (size_t)u.pm * tstepA; u.b = B + (size_t)u.pn * tstepB; u.b2 = u.b; u.ridx = nullptr; u.nrows = 0; u.e = 0; u.lt = 0; return true;
    }
    __device__ __forceinline__ void a_ready(const Unit& u, int wid, int lane) const {
        if (wait_cnt) {
            if (wid == 0) { unsigned polls = 0;
                while ((unsigned)__builtin_amdgcn_readfirstlane(__hip_atomic_load(wait_cnt + 64 * u.pm, __ATOMIC_RELAXED, __HIP_MEMORY_SCOPE_AGENT)) < need) {
                    if (++polls > (1u << 20)) { if (lane == 0) __hip_atomic_store(tmo, 1u, __ATOMIC_RELAXED, __HIP_MEMORY_SCOPE_AGENT); break; }
                    __builtin_amdgcn_s_sleep(2); }
                __builtin_amdgcn_fence(__ATOMIC_ACQUIRE, "agent");
                asm volatile("s_waitcnt vmcnt(0)" ::: "memory"); }
            asm volatile("" ::: "memory"); __builtin_amdgcn_s_barrier(); asm volatile("" ::: "memory");
        }
    }
    __device__ __forceinline__ void done(const Unit& u, int lane) const {
        if (pub_cnt) { asm volatile("s_waitcnt vmcnt(0)" ::: "memory");
            if (lane == 0) __hip_atomic_fetch_add(pub_cnt + 64 * u.pm, 1u, __ATOMIC_RELAXED, __HIP_MEMORY_SCOPE_AGENT); }
    }
};
__device__ __forceinline__ void pair_of(int cl, int& ea, int& eb) { const int g = cl / 6, pi = cl - g * 6; const int a = pi < 3 ? 0 : (pi < 5 ? 1 : 2), b = pi < 3 ? pi + 1 : (pi < 5 ? pi - 1 : 3); ea = g * 4 + a; eb = g * 4 + b; }
__device__ __forceinline__ int class_of_tile(const LAS int* tb, int tau) { int c = 0;
#pragma unroll
    for (int j = 1; j < NCLS; ++j) c = (tau >= tb[j]) ? j : c;
    return c; }
struct MoeOrder1 {
    const LAS int* tb; const unsigned* cnt; const char* H2; const char* WGU; const int* TOK; int G, c;
    __device__ bool next(int i, Unit& u) const {
        const int L = i * G + c; const int tau = L >> 3; if (tau >= tb[NCLS]) return false;
        const int cl = class_of_tile(tb, tau), lt = tau - tb[cl]; int ea, eb; pair_of(cl, ea, eb);
        u.pm = tau; u.pn = L & 7; u.e = cl; u.lt = lt; u.nrows = (int)cnt[cl] - lt * 256; u.ridx = TOK + (size_t)cl * T + lt * 256;
        u.a = H2; u.a2 = H2; u.b = WGU + (size_t)((u.pn < 4) ? ea : eb) * ((size_t)1024 * D * 2) + (size_t)(u.pn & 3) * ((size_t)256 * D * 2); u.b2 = u.b; return true;
    }
    unsigned* tcnt;
    const float* WW; LAS unsigned char* ldsb; mutable int par;
    __device__ __forceinline__ void a_ready(const Unit& u, int wid, int lane) const {
        const int slot = par & 1; ++par;
        const float* src = WW + ((size_t)u.e * T + u.lt * 256) * 2 + wid * 64 + lane;
        __builtin_amdgcn_global_load_lds((const unsigned*)src, (LAS unsigned*)(ldsb + LDS_EPI + slot * 2048 + wid * 256), 4, 0, 0);
    }
    __device__ __forceinline__ void done(const Unit& u, int lane) const {
        asm volatile("s_waitcnt vmcnt(0)" ::: "memory");
        if (lane == 0) __hip_atomic_fetch_add(tcnt + 64 * u.pm, 1u, __ATOMIC_RELAXED, __HIP_MEMORY_SCOPE_AGENT);
    }
};
struct MoeOrder2 {
    const LAS int* tb; const unsigned* cnt; const char* ACT; const char* WD; const int* TOK; int G, c;
    __device__ bool next(int i, Unit& u) const {
        const int L = i * G + c; const int tau = L >> 2; if (tau >= tb[NCLS]) return false;
        const int cl = class_of_tile(tb, tau), lt = tau - tb[cl]; int ea, eb; pair_of(cl, ea, eb);
        u.pm = tau; u.pn = L & 3; u.e = cl; u.lt = lt; u.nrows = (int)cnt[cl] - lt * 256; u.ridx = TOK + (size_t)cl * T + lt * 256;
        u.a = ACT + (size_t)tau * ((size_t)256 * 1024 * 2); u.a2 = u.a;
        u.b = WD + (size_t)ea * ((size_t)1024 * DE * 2) + (size_t)u.pn * ((size_t)256 * DE * 2);
        u.b2 = WD + (size_t)eb * ((size_t)1024 * DE * 2) + (size_t)u.pn * ((size_t)256 * DE * 2) - (size_t)8 * 128; return true;
    }
    unsigned* tcnt; unsigned* tmo;
    LAS unsigned char* ldsb; mutable int par;
    __device__ __forceinline__ void a_ready(const Unit& u, int wid, int lane) const {
        { const int slot = par & 1; ++par;
          if (wid < 4) __builtin_amdgcn_global_load_lds((const unsigned*)(u.ridx + wid * 64 + lane), (LAS unsigned*)(ldsb + LDS_EPI + 4096 + slot * 1024 + wid * 256), 4, 0, 0); }
        if (wid == 0) {
            unsigned polls = 0;
            while ((unsigned)__builtin_amdgcn_readfirstlane(__hip_atomic_load(tcnt + 64 * u.pm, __ATOMIC_RELAXED, __HIP_MEMORY_SCOPE_AGENT)) < 64u) {
                if (++polls > (1u << 20)) { if (lane == 0) __hip_atomic_store(tmo, 1u, __ATOMIC_RELAXED, __HIP_MEMORY_SCOPE_AGENT); break; }
                __builtin_amdgcn_s_sleep(2); }
            __builtin_amdgcn_fence(__ATOMIC_ACQUIRE, "agent");
            asm volatile("s_waitcnt vmcnt(0)" ::: "memory");
        }
        asm volatile("" ::: "memory"); __builtin_amdgcn_s_barrier(); asm volatile("" ::: "memory");
    }
    __device__ __forceinline__ void done(const Unit&, int) const {}
};
}

using pg8::Unit;
typedef f32x4 AccT[2][2][4][2];
#define OPAQUE(x) asm volatile("" : "+v"(x))
struct EpiInProj {
    static constexpr int PERM = 2;
    bf16 *d0, *d1, *d2, *d3, *d4, *d5, *d6; const float* qg; const float* kg; float* vstatp; LAS float* tab;
    __device__ __forceinline__ void operator()(const AccT& acc, const Unit& u, int wr, int wc, int fr, int fq) const {
        const int seg = u.pn >> 2; char* base = (char*)(seg == 0 ? d0 : seg == 1 ? d1 : seg == 2 ? d2 : seg == 3 ? d3 : seg == 4 ? d4 : seg == 5 ? d5 : d6);
        unsigned ob = (unsigned)((u.pm * 256 + wr * 64 + (fr & ~1)) * D + (u.pn & 3) * 256 + wc * 64) * 2u + (unsigned)((fr & 1) * 64 + fq * 16); OPAQUE(ob);
        if (seg >= 5) {
            unsigned og = (unsigned)((u.pm * 256 + wr * 64 + fr) * D + (u.pn - 20) * 128 + wc * 32 + 8 * fq) * 2u; OPAQUE(og);
#pragma unroll
            for (int ai = 0; ai < 2; ++ai)
#pragma unroll
                for (int m = 0; m < 4; ++m) { const unsigned o = og + (unsigned)((ai * 128 + m * 16) * D * 2);
                    const f32x4 ea0 = exp2_4(acc[ai][0][m][0] * (-LOG2E)) + 1.0f, ea1 = exp2_4(acc[ai][0][m][1] * (-LOG2E)) + 1.0f;
                    const f32x4 eb0 = exp2_4(acc[ai][1][m][0] * (-LOG2E)) + 1.0f, eb1 = exp2_4(acc[ai][1][m][1] * (-LOG2E)) + 1.0f;
                    const f32x4 i0 = rcp_4(ea0 * eb0), i1 = rcp_4(ea1 * eb1);
                    u32x4 w; w.x = q255x4(eb0 * i0, 0.0f); w.y = q255x4(eb1 * i1, 0.0f); w.z = q255x4(ea0 * i0, 1.0f); w.w = q255x4(ea1 * i1, 1.0f);
                    st16_ntwt(d5, o, w); }
            return;
        }
        if (seg == 0 || seg == 4) {
            const bool odd = (fr & 1) != 0;
#pragma unroll
            for (int ai = 0; ai < 2; ++ai)
#pragma unroll
                for (int m = 0; m < 4; ++m) { const unsigned o = ob + (unsigned)((ai * 128 + m * 16) * D * 2);
                    u32x4 w[2];
#pragma unroll
                    for (int bj = 0; bj < 2; ++bj) { f32x4 v0 = acc[ai][bj][m][0], v1 = acc[ai][bj][m][1];
                        w[bj].x = cvt_pk_bf16(v0[0], v0[1]); w[bj].y = cvt_pk_bf16(v0[2], v0[3]); w[bj].z = cvt_pk_bf16(v1[0], v1[1]); w[bj].w = cvt_pk_bf16(v1[2], v1[3]); }
                    st_lines_ntwt(base, o, D * 2, w[0], w[1], odd); }
            return;
        }
        if (seg == 1) stat_tile<true>(acc, u, wr, wc, fr, fq, base, ob, seg); else stat_tile<false>(acc, u, wr, wc, fr, fq, base, ob, seg);
    }
    template <bool GELU> __device__ __forceinline__ void stat_tile(const AccT& acc, const Unit& u, int wr, int wc, int fr, int fq, char* base, unsigned ob, int seg) const {
        int fr_ = fr, fq_ = fq; OPAQUE(fr_); OPAQUE(fq_);
        const int rowl = wr * 64 + fr_;
        const bool odd = (fr_ & 1) != 0;
        const int tslot = GELU ? wc : ((wc >> 1) * 1024 + (wc & 1) * 2);
        f32x4 g00, g01, g10, g11;
        if constexpr (!GELU) { const float* gv = (seg == 2 ? qg : kg) + (wc & 1) * 64 + 8 * fq_; const float gs = (seg == 2) ? QSCALE : 1.0f;
            g00 = *(const f32x4*)gv * gs; g01 = *(const f32x4*)(gv + 4) * gs; g10 = *(const f32x4*)(gv + 32) * gs; g11 = *(const f32x4*)(gv + 36) * gs; }
#pragma unroll
        for (int ai = 0; ai < 2; ++ai)
#pragma unroll
            for (int m = 0; m < 4; ++m) { const unsigned o = ob + (unsigned)((ai * 128 + m * 16) * D * 2);
                u32x4 w[2];
#pragma unroll
                for (int bj = 0; bj < 2; ++bj) { f32x4 v0 = acc[ai][bj][m][0], v1 = acc[ai][bj][m][1];
                    if constexpr (GELU) {
                        v0 = gelu4(v0); v1 = gelu4(v1);
                        w[bj].x = cvt_pk_bf16(v0[0], v0[1]); w[bj].y = cvt_pk_bf16(v0[2], v0[3]); w[bj].z = cvt_pk_bf16(v1[0], v1[1]); w[bj].w = cvt_pk_bf16(v1[2], v1[3]); }
                    float sq = (v0[0] * v0[0] + v0[1] * v0[1]) + (v0[2] * v0[2] + v0[3] * v0[3]) + (v1[0] * v1[0] + v1[1] * v1[1]) + (v1[2] * v1[2] + v1[3] * v1[3]);
                    sq = rows_sum(sq);
                    if (fq_ == 0) tab[(GELU ? bj * 1024 : bj) + (ai * 128 + m * 16 + rowl) * 4 + tslot] = sq; }
                if constexpr (GELU) st_lines_ntwt(base, o, D * 2, w[0], w[1], odd); }
        asm volatile("s_waitcnt lgkmcnt(0)" ::: "memory"); __builtin_amdgcn_s_barrier(); asm volatile("" ::: "memory");
        if constexpr (GELU) {
            if (wc == 0 && fq_ == 0) {
#pragma unroll
                for (int ai = 0; ai < 2; ++ai)
#pragma unroll
                    for (int m = 0; m < 4; ++m) { const int rl = ai * 128 + m * 16 + rowl;
                        const f32x4 t0 = *(const LAS f32x4*)(tab + (rl) * 4), t1 = *(const LAS f32x4*)(tab + (256 + rl) * 4);
                        vstatp[(size_t)(u.pn & 3) * T + u.pm * 256 + rl] = ((t0.x + t0.y) + (t0.z + t0.w)) + ((t1.x + t1.y) + (t1.z + t1.w)); } }
        } else {
#pragma unroll
            for (int ai = 0; ai < 2; ++ai)
#pragma unroll
                for (int m = 0; m < 4; ++m) { const unsigned o = ob + (unsigned)((ai * 128 + m * 16) * D * 2);
                    const int rl = ai * 128 + m * 16 + rowl;
                    const f32x4 t0 = *(const LAS f32x4*)(tab + ((wc >> 1) * 256 + rl) * 4);
                    const float rr = 1.0f / sqrtf(((t0.x + t0.y) + (t0.z + t0.w)) * (1.0f / DH) + EPS);
                    const f32x4 a0 = acc[ai][0][m][0] * rr * g00, a1 = acc[ai][0][m][1] * rr * g01, b0 = acc[ai][1][m][0] * rr * g10, b1 = acc[ai][1][m][1] * rr * g11;
                    u32x4 w0, w1; w0.x = cvt_pk_bf16(a0[0], a0[1]); w0.y = cvt_pk_bf16(a0[2], a0[3]); w0.z = cvt_pk_bf16(a1[0], a1[1]); w0.w = cvt_pk_bf16(a1[2], a1[3]);
                    w1.x = cvt_pk_bf16(b0[0], b0[1]); w1.y = cvt_pk_bf16(b0[2], b0[3]); w1.z = cvt_pk_bf16(b1[0], b1[1]); w1.w = cvt_pk_bf16(b1[2], b1[3]);
                    st_lines_ntwt(base, o, D * 2, w0, w1, odd);
                    asm volatile("" ::: "memory"); }
        }
    }
};
struct EpiProjAB {
    static constexpr int PERM = 2;
    const bf16* SA; const bf16* SB; bf16* MG;
    __device__ __forceinline__ void mid(AccT& acc, const Unit& u, int wr, int wc, int fr, int fq) const {
        unsigned ob = (unsigned)((u.pm * 256 + wr * 64 + (fr & ~1)) * D + u.pn * 256 + wc * 64) * 2u + (unsigned)((fr & 1) * 64 + fq * 16); OPAQUE(ob);
        const bool odd = (fr & 1) != 0;
#pragma unroll
        for (int ai = 0; ai < 2; ++ai)
#pragma unroll
            for (int m = 0; m < 4; ++m) { const unsigned o = ob + (unsigned)((ai * 128 + m * 16) * D * 2);
                u32x4 av[2]; ld_lines_fix(*(const u32x4*)((const char*)SA + o), *(const u32x4*)((const char*)SA + o + D * 2), odd, av[0], av[1]);
#pragma unroll
                for (int bj = 0; bj < 2; ++bj) { const u32x4 a = av[bj];
                    acc[ai][bj][m][0] = acc[ai][bj][m][0] * (ub4(a.x) * rcp_4(ub4(a.z))); acc[ai][bj][m][1] = acc[ai][bj][m][1] * (ub4(a.y) * rcp_4(ub4(a.w))); }
                if (m == 3) asm volatile("" ::: "memory"); }
    }
    __device__ __forceinline__ void operator()(const AccT& acc, const Unit& u, int wr, int wc, int fr, int fq) const {
        unsigned os = (unsigned)((u.pm * 256 + wr * 64 + (fr & ~1)) * D + u.pn * 256 + wc * 64) * 2u + (unsigned)((fr & 1) * 64 + fq * 16); OPAQUE(os);
        const bool odd = (fr & 1) != 0;
#pragma unroll
        for (int ai = 0; ai < 2; ++ai) {
            u32x4 bv[4][2];
#pragma unroll
            for (int m = 0; m < 4; ++m)
#pragma unroll
                for (int bj = 0; bj < 2; ++bj) bv[m][bj] = *(const u32x4*)((const char*)SA + os + (unsigned)((ai * 128 + m * 16 + bj) * D * 2));
#pragma unroll
            for (int m = 0; m < 4; ++m) { u32x4 w[2], bb[2]; ld_lines_fix(bv[m][0], bv[m][1], odd, bb[0], bb[1]);
#pragma unroll
                for (int bj = 0; bj < 2; ++bj) { const u32x4 b = bb[bj]; const f32x4 v0 = acc[ai][bj][m][0] * (ub4(b.z) * (1.0f / 255.0f)), v1 = acc[ai][bj][m][1] * (ub4(b.w) * (1.0f / 255.0f));
                    w[bj].x = cvt_pk_bf16(v0[0], v0[1]); w[bj].y = cvt_pk_bf16(v0[2], v0[3]); w[bj].z = cvt_pk_bf16(v1[0], v1[1]); w[bj].w = cvt_pk_bf16(v1[2], v1[3]); }
                st_lines_wt(MG, os + (unsigned)((ai * 128 + m * 16) * D * 2), D * 2, w[0], w[1], odd); }
            asm volatile("" ::: "memory"); }
    }
};
struct EpiOut {
    static constexpr int PERM = 2;
    const float* x; const float* mod; bf16* x1;
    __device__ __forceinline__ void operator()(const AccT& acc, const Unit& u, int wr, int wc, int fr, int fq) const {
        int col0 = u.pn * 256 + wc * 64 + 8 * fq; OPAQUE(col0);
        unsigned ob = (unsigned)((u.pm * 256 + wr * 64 + fr) * D + col0) * 4u; OPAQUE(ob);
        unsigned os = (unsigned)((u.pm * 256 + wr * 64 + (fr & ~1)) * D + u.pn * 256 + wc * 64) * 2u + (unsigned)((fr & 1) * 64 + fq * 16); OPAQUE(os);
        const bool odd = (fr & 1) != 0;
        const float* gate = (const float*)((const char*)mod + (unsigned)((((u.pm * 256) >> 11) * 6144 + 2048 + col0) * 4));
        f32x4 g[2][2];
#pragma unroll
        for (int bj = 0; bj < 2; ++bj)
#pragma unroll
            for (int n = 0; n < 2; ++n) g[bj][n] = *(const f32x4*)(gate + bj * 32 + n * 4);
#pragma unroll
        for (int ai = 0; ai < 2; ++ai) {
            f32x4 xv[4][2][2];
#pragma unroll
            for (int m = 0; m < 4; ++m)
#pragma unroll
                for (int bj = 0; bj < 2; ++bj)
#pragma unroll
                    for (int n = 0; n < 2; ++n) xv[m][bj][n] = *(const f32x4*)((const char*)x + ob + (unsigned)((ai * 128 + m * 16) * D * 4) + bj * 128 + n * 16);
#pragma unroll
            for (int m = 0; m < 4; ++m) { u32x4 w[2];
#pragma unroll
                for (int bj = 0; bj < 2; ++bj) { const f32x4 r0 = xv[m][bj][0] + g[bj][0] * acc[ai][bj][m][0], r1 = xv[m][bj][1] + g[bj][1] * acc[ai][bj][m][1];
                    w[bj].x = cvt_pk_bf16(r0[0], r0[1]); w[bj].y = cvt_pk_bf16(r0[2], r0[3]); w[bj].z = cvt_pk_bf16(r1[0], r1[1]); w[bj].w = cvt_pk_bf16(r1[2], r1[3]); }
                st_lines_wt(x1, os + (unsigned)((ai * 128 + m * 16) * D * 2), D * 2, w[0], w[1], odd); }
            asm volatile("" ::: "memory"); }
    }
};
struct EpiMoe1 {
    static constexpr int PERM = 1;
    bf16* ACT; LAS unsigned char* ldsb; mutable int par;
    __device__ __forceinline__ void operator()(const AccT& acc, const Unit& u, int wr, int wc, int fr, int fq) const {
        const int half = u.pn >> 2; const int slot = par & 1; ++par;
        unsigned ob = (unsigned)((u.pm * 256 + wr * 64 + fr) * 1024 + half * 512 + (u.pn & 3) * 128 + wc * 32 + 8 * fq) * 2u; OPAQUE(ob);
        const LAS float* wl = (const LAS float*)(ldsb + LDS_EPI + slot * 2048) + half;
        int fr_ = fr; OPAQUE(fr_);
#pragma unroll
        for (int ai = 0; ai < 2; ++ai)
#pragma unroll
            for (int m = 0; m < 4; ++m) { const int lr = ai * 128 + wr * 64 + m * 16 + fr_; const float w = (lr < u.nrows) ? wl[lr * 2] : 0.f;
                const f32x4 g0 = acc[ai][0][m][0], g1 = acc[ai][0][m][1];
                const f32x4 a0 = g0 * sigmoid4(g0) * (acc[ai][1][m][0] * w), a1 = g1 * sigmoid4(g1) * (acc[ai][1][m][1] * w);
                u32x4 ww; ww.x = cvt_pk_bf16(a0[0], a0[1]); ww.y = cvt_pk_bf16(a0[2], a0[3]); ww.z = cvt_pk_bf16(a1[0], a1[1]); ww.w = cvt_pk_bf16(a1[2], a1[3]);
                st16_wt(ACT, ob + (unsigned)((ai * 128 + m * 16) * 1024 * 2), ww); }
    }
};
struct EpiMoe2 {
    static constexpr int PERM = 0;
    float* out; const float* mod; const bf16* x1; LAS unsigned char* ldsb; mutable int par;
    __device__ __forceinline__ void operator()(const AccT& acc, const Unit& u, int wr, int wc, int fr, int fq) const {
        const LAS int* tokl = (const LAS int*)(ldsb + LDS_EPI + 4096 + (par & 1) * 1024); ++par;
        int col0 = u.pn * 256 + wc * 32 + 4 * fq; OPAQUE(col0);
        int colx = u.pn * 256 + wc * 32 + 8 * (fq >> 1) + 16 * (fq & 1); OPAQUE(colx);
        int fr_ = fr; OPAQUE(fr_);
        const bool odd = (fr_ & 1) != 0;
        int tok[2][4];
#pragma unroll
        for (int ai = 0; ai < 2; ++ai)
#pragma unroll
            for (int m = 0; m < 4; ++m) { const int lr = ai * 128 + wr * 64 + m * 16 + fr_; tok[ai][m] = (lr < u.nrows) ? tokl[lr] : -1; }
#pragma unroll
        for (int ai = 0; ai < 2; ++ai) {
            u32x4 xl[4][2];
#pragma unroll
            for (int m = 0; m < 4; ++m) { const bf16* xp = x1 + (size_t)(tok[ai][m] < 0 ? 0 : tok[ai][m]) * D + colx;
#pragma unroll
                for (int bj = 0; bj < 2; ++bj) xl[m][bj] = *(const u32x4*)(xp + bj * 128); }
#pragma unroll
            for (int m = 0; m < 4; ++m) { const int tk = tok[ai][m]; const int tn = (int)dpp_swap1((unsigned)tk); const int te = odd ? tn : tk, to = odd ? tk : tn;
                const float* gp = mod + (size_t)((tk < 0 ? 0 : tk) >> 11) * 6144 + 5120 + col0;
                const unsigned oe = (unsigned)((te < 0 ? 0 : te) * D + col0 + (odd ? 16 : 0)) * 4u, oo = (unsigned)((to < 0 ? 0 : to) * D + col0 + (odd ? 16 : 0)) * 4u;
#pragma unroll
                for (int bj = 0; bj < 2; ++bj) { const f32x4 g0 = *(const f32x4*)(gp + bj * 128), g1 = *(const f32x4*)(gp + bj * 128 + 16);
                    const auto s0 = __builtin_amdgcn_permlane16_swap(xl[m][bj].x, xl[m][bj].z, false, false); const auto s1 = __builtin_amdgcn_permlane16_swap(xl[m][bj].y, xl[m][bj].w, false, false);
                    const f32x4 x0 = {bflo(s0[0]), bfhi(s0[0]), bflo(s1[0]), bfhi(s1[0])}, x1v = {bflo(s0[1]), bfhi(s0[1]), bflo(s1[1]), bfhi(s1[1])};
                    const u32x4 r0 = __builtin_bit_cast(u32x4, x0 + g0 * acc[ai][bj][m][0]), r1 = __builtin_bit_cast(u32x4, x1v + g1 * acc[ai][bj][m][1]);
                    const u32x4 x = odd ? r0 : r1; u32x4 y; y.x = dpp_swap1(x.x); y.y = dpp_swap1(x.y); y.z = dpp_swap1(x.z); y.w = dpp_swap1(x.w);
                    if (te >= 0) st16_ntwt(out, oe + bj * 512, odd ? y : r0);
                    if (to >= 0) st16_ntwt(out, oo + bj * 512, odd ? r1 : y); } }
            asm volatile("" ::: "memory"); }
    }
};

namespace att {
typedef float f32x16 __attribute__((ext_vector_type(16)));
typedef short s16x4 __attribute__((ext_vector_type(4)));
#define KSWZ(row, colB) ((row) * 256 + ((colB) ^ (((row) & 7) << 4)))
__device__ __forceinline__ int crow(int r, int hi) { return (r & 3) + 8 * (r >> 2) + 4 * hi; }
__device__ __forceinline__ int v_st(int k, int c) { const int kk = (k & ~0xC) | ((k & 4) << 1) | ((k & 8) >> 1); return ((kk >> 3) * 4 + (c >> 5)) * 512 + ((kk & 7) * 32 + (c & 31)) * 2; }
__device__ __forceinline__ int v_rd_base(int lane) { return ((lane & 3) << 3) | (((lane >> 2) & 3) << 6) | (((lane >> 4) & 1) << 5) | (((lane >> 5) & 1) << 8); }
constexpr int v_rd_off(int d0, int ks, int half) { return d0 * 512 + ks * 4096 + half * 2048; }
template <int OFF> __device__ __forceinline__ s16x4 tr_read(int vb) {
    s16x4 r; asm volatile("ds_read_b64_tr_b16 %0, %1 offset:%2" : "=&v"(r) : "v"(vb), "i"(OFF) : "memory"); return r;
}
template <int D0> __device__ __forceinline__ void pv_two(f32x16& oa, f32x16& ob2, int vb, bf16x8 pa0, bf16x8 pa1) {
    const s16x4 l0 = tr_read<v_rd_off(D0, 0, 0)>(vb), h0 = tr_read<v_rd_off(D0, 0, 1)>(vb), l1 = tr_read<v_rd_off(D0, 1, 0)>(vb), h1 = tr_read<v_rd_off(D0, 1, 1)>(vb);
    const s16x4 m0 = tr_read<v_rd_off(D0 + 1, 0, 0)>(vb), n0 = tr_read<v_rd_off(D0 + 1, 0, 1)>(vb), m1 = tr_read<v_rd_off(D0 + 1, 1, 0)>(vb), n1 = tr_read<v_rd_off(D0 + 1, 1, 1)>(vb);
    asm volatile("s_waitcnt lgkmcnt(0)" ::: "memory"); __builtin_amdgcn_sched_barrier(0);
#define PKV(L_, H_) (bf16x8){L_[0], L_[1], L_[2], L_[3], H_[0], H_[1], H_[2], H_[3]}
    oa = __builtin_amdgcn_mfma_f32_32x32x16_bf16(pa0, PKV(l0, h0), oa, 0, 0, 0);
    ob2 = __builtin_amdgcn_mfma_f32_32x32x16_bf16(pa0, PKV(m0, n0), ob2, 0, 0, 0);
    oa = __builtin_amdgcn_mfma_f32_32x32x16_bf16(pa1, PKV(l1, h1), oa, 0, 0, 0);
    ob2 = __builtin_amdgcn_mfma_f32_32x32x16_bf16(pa1, PKV(m1, n1), ob2, 0, 0, 0);
#undef PKV
}
template <int MODE>
__device__ __forceinline__ void class_block(f32x16 (&o)[4], float& lsum, const bf16x8 (&qr)[8], int kbase  , int vb  ,
                                            int r32, int hi, int Lq, int rel, int r, int cls, float negM2) {
    f32x16 p;
#pragma unroll
    for (int i = 0; i < 16; ++i) p[i] = negM2;
    int r32_ = r32, hi_ = hi; OPAQUE(r32_); OPAQUE(hi_);
    bf16x8 kf[8];
#pragma unroll
    for (int d0 = 0; d0 < 8; ++d0) { const int cb = (d0 * 16 + hi_ * 8) * 2; kf[d0] = *(const LAS bf16x8*)((LAS unsigned char*)(size_t)0 + kbase + KSWZ(r32_, cb)); }
#pragma unroll
    for (int d0 = 0; d0 < 8; ++d0) p = __builtin_amdgcn_mfma_f32_32x32x16_bf16(kf[d0], qr[d0], p, 0, 0, 0);
    const int Bv = 128 * rel + (r - cls);
    const int lo1 = -(Bv >> 2), hi1 = (128 - Bv) >> 2;
    float ls = 0.f;
    if constexpr (MODE == 0) {
#pragma unroll
        for (int i = 0; i < 16; ++i) { const int creg = (i & 3) + 8 * (i >> 2); const float e = __builtin_amdgcn_exp2f(p[i]); const bool m3 = ((Lq & 3) == (creg & 3)); p[i] = m3 ? e : 0.f; ls += p[i]; }
    } else if constexpr (MODE == 2) {
        const int sg = (rel == 0) ? 1 : -1, th = (rel == 0) ? lo1 : -hi1; const int sLq = sg * Lq;
#pragma unroll
        for (int i = 0; i < 16; ++i) { const int creg = (i & 3) + 8 * (i >> 2); const float e = __builtin_amdgcn_exp2f(p[i]); p[i] = (sLq >= th + sg * creg) ? e : 0.f; ls += p[i]; }
    } else {
        const int sg = (rel == 1 || rel == 4) ? -1 : 1; const int sLq = sg * Lq;
        const float wT0 = (rel == 0 || rel == 1) ? 2.f : 1.f, wF0 = (rel == 0 || rel == 4) ? 0.f : 1.f, wFm = (rel == 0) ? 0.f : 1.f;
        float hT[4], hF[4];
#pragma unroll
        for (int q = 0; q < 4; ++q) { const bool m3 = ((Lq & 3) == q); hT[q] = m3 ? wT0 + 1.f : wT0; hF[q] = m3 ? wF0 + wFm : wF0; }
#pragma unroll
        for (int i = 0; i < 16; ++i) { const int creg = (i & 3) + 8 * (i >> 2); const float e = __builtin_amdgcn_exp2f(p[i]);
            const float w = (sLq >= sg * creg) ? hT[i & 3] : hF[i & 3]; p[i] = e * w; ls += p[i]; }
    }
    lsum += ls;
    bf16x8 pa0, pa1;
#define PK4(P_, BASE, OUT) do { unsigned a0 = cvt_pk_bf16(P_[BASE + 0], P_[BASE + 1]), a1 = cvt_pk_bf16(P_[BASE + 2], P_[BASE + 3]);   \
        unsigned b0 = cvt_pk_bf16(P_[BASE + 4], P_[BASE + 5]), b1 = cvt_pk_bf16(P_[BASE + 6], P_[BASE + 7]);                              \
        auto r0 = __builtin_amdgcn_permlane32_swap(a0, b0, false, false); auto r1 = __builtin_amdgcn_permlane32_swap(a1, b1, false, false); \
        u32x4 w_ = {r0[0], r1[0], r0[1], r1[1]}; OUT = *reinterpret_cast<bf16x8*>(&w_); } while (0)
    PK4(p, 0, pa0); PK4(p, 8, pa1);
#undef PK4
    pv_two<0>(o[0], o[1], vb, pa0, pa1); pv_two<2>(o[2], o[3], vb, pa0, pa1);
}
__device__ __forceinline__ void attn_phase(const bf16* Kb, const bf16* Vb, bf16* QO, const float* qg, const float* kg, unsigned char* lds_g, int vcu, int G, const int TID) {
    const int tid = TID, wid = __builtin_amdgcn_readfirstlane(tid >> 6), lane = tid & 63, r32 = lane & 31, hi = lane >> 5;
    const int r = wid & 3, hf = wid >> 2;
    const int lds0 = (int)(size_t)(LAS unsigned char*)lds_g;
    float* li_l = (float*)(lds_g + LDS_EPI + 4096) + wid * 64;
    float gq = fmaxf(fabsf(qg[lane]), fabsf(qg[lane + 64])), gk = fmaxf(fabsf(kg[lane]), fabsf(kg[lane + 64]));
#pragma unroll
    for (int o_ = 1; o_ < 64; o_ <<= 1) { gq = fmaxf(gq, __shfl_xor(gq, o_)); gk = fmaxf(gk, __shfl_xor(gk, o_)); }
    const float negM2 = -11.313708498984761f * LOG2E * gq * gk;
    const int Lq = r32 - 4 * hi;
    const int sr = tid >> 4, sc = (tid & 15) * 8;
    const int scls = sr & 3;
#define SDMA(Kp, Vp, c, bf) do { int ln_ = lane; OPAQUE(ln_); const int cls_ = wid >> 1, w1_ = wid & 1; \
            const unsigned cbase_ = (unsigned)(128 * (c)) * 2048u; \
            _Pragma("unroll") for (int i_ = 0; i_ < 4; ++i_) { \
                const int kidx_ = 16 * w1_ + 4 * i_ + (ln_ >> 4); const int pc_ = (ln_ & 15) ^ (kidx_ & 7); \
                const unsigned ko_ = cbase_ + (unsigned)(4 * kidx_ + cls_) * 2048u + (unsigned)pc_ * 16u; \
                __builtin_amdgcn_global_load_lds((const unsigned*)((const char*)(Kp) + ko_), (LAS unsigned*)(L3 + (bf) * 65536 + wid * 4096 + i_ * 1024), 16, 0, 0); \
                const int k_ = 16 * w1_ + 8 * ((ln_ >> 4) & 1) + 4 * (i_ >> 1) + ((ln_ >> 2) & 3); const int c_ = 32 * (2 * (i_ & 1) + (ln_ >> 5)) + 8 * (ln_ & 3); \
                const unsigned vo_ = cbase_ + (unsigned)(4 * k_ + cls_) * 2048u + (unsigned)c_ * 2u; \
                __builtin_amdgcn_global_load_lds((const unsigned*)((const char*)(Vp) + vo_), (LAS unsigned*)(L3 + (bf) * 65536 + 32768 + wid * 4096 + i_ * 1024), 16, 0, 0); } } while (0)
#define ADEC(it_, P) const int P##j = (it_) & 255, P##rr = (it_) >> 8, P##bh = (P##j >> 3) * 4 + P##rr, P##kq = P##j & 7; \
        const int P##qt = (P##rr & 1) ? 7 - P##kq : P##kq; const bool P##desc = (P##rr & 1) != 0; const size_t P##hb = (size_t)(P##bh >> 3) * S * D + (P##bh & 7) * DH
#define QLOAD(hb_, qt_) do { int r32q_ = r32; OPAQUE(r32q_); const bf16* Qw_ = QO + (hb_) + (size_t)(256 * (qt_) + 128 * hf + r + 4 * r32q_) * D + hi * 8; \
        _Pragma("unroll") for (int d0 = 0; d0 < 8; ++d0) qr[d0] = *(const bf16x8*)(Qw_ + d0 * 16); } while (0)
    LAS unsigned char* L3 = (LAS unsigned char*)lds_g;
    bf16x8 qr[8];
    if (vcu < 1024) { ADEC(vcu, f_); QLOAD(f_hb, f_qt); SDMA(Kb + f_hb, Vb + f_hb, (f_desc ? 2 * f_qt + 1 : 0), 0); }
    u32x4 od[8]; bf16* od_q = nullptr; int od_t0 = 0;
#pragma unroll
    for (int jj = 0; jj < 8; ++jj) od[jj] = (u32x4){0u, 0u, 0u, 0u};
#define OSTORE() do { int lno_ = lane; OPAQUE(lno_); _Pragma("unroll") for (int jj = 0; jj < 8; ++jj) { const int idx = jj * 64 + lno_, q = idx >> 4, pc = idx & 15; \
            st16_wt(od_q, (unsigned)((od_t0 + 128 * hf + r + 4 * q) * D + pc * 8) * 2u, od[jj]); } } while (0)
    for (int it = vcu; it < 1024; it += G) {
        ADEC(it, );
        const int t0 = 256 * qt, cq = 2 * qt + hf, nch = 2 * qt + 2;
        const bf16* Kh = Kb + hb; const bf16* Vh = Vb + hb; bf16* Qh = QO + hb;
        f32x16 o[4];
#pragma unroll
        for (int d = 0; d < 4; ++d)
#pragma unroll
            for (int i = 0; i < 16; ++i) o[d][i] = 0.f;
        float lsum = 0.f;
        __syncthreads();
        if (od_q != nullptr) OSTORE();
        for (int ci = 0; ci < nch; ++ci) {
            const int bf = ci & 1; const int c = desc ? nch - 1 - ci : ci;
            if (ci + 1 < nch) SDMA(Kh, Vh, (desc ? c - 1 : c + 1), bf ^ 1);
            const int rel = cq - c;
            const int kb0 = lds0 + bf * 65536, vb0 = lds0 + bf * 65536 + 32768 + v_rd_base(lane);
            if (rel >= 5) { class_block<0>(o, lsum, qr, kb0 + r * 8192, vb0 + r * 8192, r32, hi, Lq, rel, r, r, negM2); }
            else if (rel >= 0) {
                class_block<1>(o, lsum, qr, kb0 + r * 8192, vb0 + r * 8192, r32, hi, Lq, rel, r, r, negM2);
                if (rel < 2) {
#pragma unroll 1
                    for (int k = 1; k < 4; ++k) { const int cls = (r + k) & 3; class_block<2>(o, lsum, qr, kb0 + cls * 8192, vb0 + cls * 8192, r32, hi, Lq, rel, r, cls, negM2); } }
            }
            __syncthreads();
        }
        if (it + G < 1024) { ADEC(it + G, n_); QLOAD(n_hb, n_qt); SDMA(Kb + n_hb, Vb + n_hb, (n_desc ? 2 * n_qt + 1 : 0), 0); }
        { const float lt = lsum + __shfl_xor(lsum, 32);
          if (hi == 0) li_l[r32] = lt; }
        asm volatile("s_waitcnt lgkmcnt(0)" ::: "memory");
        unsigned short* ot = (unsigned short*)(lds_g + 65536 + wid * 8704);
#pragma unroll
        for (int i = 0; i < 16; ++i) { const int q = crow(i, hi); const float rli = __builtin_amdgcn_rcpf(li_l[q]);
#pragma unroll
            for (int d0 = 0; d0 < 4; ++d0) ot[q * 136 + d0 * 32 + r32] = (unsigned short)f2bf(o[d0][i] * rli); }
        asm volatile("s_waitcnt lgkmcnt(0)" ::: "memory");
#pragma unroll
        for (int jj = 0; jj < 8; ++jj) { const int idx = jj * 64 + lane, q = idx >> 4, pc = idx & 15;
            od[jj] = *(const u32x4*)(ot + q * 136 + pc * 8); }
        od_q = Qh; od_t0 = t0;
        asm volatile("s_waitcnt lgkmcnt(0)" ::: "memory");
    }
    __syncthreads();
    if (od_q != nullptr) OSTORE();
#undef OSTORE
#undef SDMA
#undef ADEC
#undef QLOAD
}
#undef KSWZ
}


namespace sgu {
using att::f32x16; using att::s16x4; using att::tr_read; using att::v_rd_base; using att::crow;
template <int KS> __device__ __forceinline__ void kstep(f32x16& a0, f32x16& a1, int vb, const bf16x8 af, int nks) {
    if (KS < nks) {
        const s16x4 l0 = tr_read<KS * 4096>(vb), h0 = tr_read<KS * 4096 + 2048>(vb), l1 = tr_read<KS * 4096 + 512>(vb), h1 = tr_read<KS * 4096 + 2048 + 512>(vb);
        asm volatile("s_waitcnt lgkmcnt(0)" ::: "memory"); __builtin_amdgcn_sched_barrier(0);
#define PKV(L_, H_) (bf16x8){L_[0], L_[1], L_[2], L_[3], H_[0], H_[1], H_[2], H_[3]}
        a0 = __builtin_amdgcn_mfma_f32_32x32x16_bf16(af, PKV(l0, h0), a0, 0, 0, 0);
        a1 = __builtin_amdgcn_mfma_f32_32x32x16_bf16(af, PKV(l1, h1), a1, 0, 0, 0);
#undef PKV
    }
}
__device__ __forceinline__ void sgu_phase(const bf16* GU, const bf16* GV, const float* vstat, const float* gn, const bf16* SW, const float* sgu_b, bf16* SG, unsigned char* lds_g, int vcu, int G, const int TID) {
    const int tid = TID, wid = __builtin_amdgcn_readfirstlane(tid >> 6), lane = tid & 63, r32 = lane & 31, hi = lane >> 5;
    const int tb = wid & 3, ch2 = wid >> 2;
    LAS unsigned char* L3 = (LAS unsigned char*)lds_g;
    const int lds0 = (int)(size_t)L3;
    float* ot = (float*)(lds_g + 65536 + wid * 8704);
    float* rsl = (float*)(lds_g + 135168);
    constexpr int NIT = (T / 128) * 8;
#define GDMA(item, bf) do { const int cj_ = (item) >> 3, g_ = (item) & 7; int ln_ = lane; OPAQUE(ln_); \
        _Pragma("unroll") for (int i_ = 0; i_ < 4; ++i_) { const int sp_ = 4 * wid + i_; \
            const int kk_ = 8 * (sp_ >> 1) + ((ln_ & 31) >> 2); const int k_ = (kk_ & ~0xC) | ((kk_ & 4) << 1) | ((kk_ & 8) >> 1); \
            const int c_ = 32 * (2 * (sp_ & 1) + (ln_ >> 5)) + 8 * (ln_ & 3); \
            const unsigned go_ = (unsigned)((cj_ * 128 + k_) * D + g_ * 128 + c_) * 2u; \
            __builtin_amdgcn_global_load_lds((const unsigned*)((const char*)GV + go_), (LAS unsigned*)(L3 + (bf) * 32768 + sp_ * 1024), 16, 0, 0); } } while (0)
    int it = vcu, bf = 0;
    if (it < NIT) { GDMA(it, 0);
        if (tid < 128) { const float* vp = vstat + (it >> 3) * 128 + tid; rsl[tid] = 1.0f / sqrtf(((vp[0] + vp[T]) + (vp[2 * T] + vp[3 * T])) * (1.0f / D) + EPS); } }
    int g_have = -1; u32x4 wvs[8]; f32x4 bs4[4]; float gn0 = 0.f, gn1 = 0.f;
#pragma unroll
    for (int i = 0; i < 8; ++i) wvs[i] = (u32x4){0u, 0u, 0u, 0u};
#pragma unroll
    for (int i = 0; i < 4; ++i) bs4[i] = (f32x4){0.f, 0.f, 0.f, 0.f};
    u32x4 wout[4]; int row0_prev = -1, g_prev = 0;
#pragma unroll
    for (int jj = 0; jj < 4; ++jj) wout[jj] = (u32x4){0u, 0u, 0u, 0u};
#define SGSTORE() do { _Pragma("unroll") for (int jj = 0; jj < 4; ++jj) { const int idx = jj * 64 + lane, q = idx >> 3, pc = idx & 7; \
            st16_wt(SG, (unsigned)((row0_prev + 32 * tb + q) * D + g_prev * 128 + ch2 * 64 + pc * 8) * 2u, wout[jj]); } } while (0)
    for (; it < NIT; it += G, bf ^= 1) {
        asm volatile("s_waitcnt vmcnt(0)\n\ts_waitcnt lgkmcnt(0)" ::: "memory"); __builtin_amdgcn_s_barrier(); asm volatile("" ::: "memory");
        if (row0_prev >= 0) SGSTORE();
        const bool more = it + G < NIT;
        const int cj = it >> 3, g = it & 7, row0 = cj * 128;
        if (g != g_have) { g_have = g; const bf16* wrow_ = SW + ((size_t)g * 128 + 32 * tb + r32) * 128 + 8 * hi;
#pragma unroll
            for (int i = 0; i < 8; ++i) wvs[i] = *(const u32x4*)(wrow_ + 16 * i);
#pragma unroll
            for (int i = 0; i < 4; ++i) bs4[i] = *(const f32x4*)(sgu_b + g * 128 + 32 * tb + 8 * i + 4 * hi);
            gn0 = gn[g * 128 + ch2 * 64 + r32]; gn1 = gn[g * 128 + ch2 * 64 + 32 + r32];
#pragma unroll
            for (int i = 0; i < 8; ++i) { OPAQUE(wvs[i].x); OPAQUE(wvs[i].y); OPAQUE(wvs[i].z); OPAQUE(wvs[i].w); }
#pragma unroll
            for (int i = 0; i < 4; ++i) { OPAQUE(bs4[i].x); OPAQUE(bs4[i].y); OPAQUE(bs4[i].z); OPAQUE(bs4[i].w); }
            OPAQUE(gn0); OPAQUE(gn1); }
        float vn0, vn1, vn2, vn3;
        { const float* vp = vstat + ((more ? it + G : it) >> 3) * 128 + (tid & 127);
          asm volatile("global_load_dword %0, %1, off" : "=v"(vn0) : "v"(vp)); asm volatile("global_load_dword %0, %1, off" : "=v"(vn1) : "v"(vp + T));
          asm volatile("global_load_dword %0, %1, off" : "=v"(vn2) : "v"(vp + 2 * T)); asm volatile("global_load_dword %0, %1, off" : "=v"(vn3) : "v"(vp + 3 * T)); }
        u32x4 uv[4];
#pragma unroll
        for (int jj = 0; jj < 4; ++jj) { const int idx = jj * 64 + lane, q = idx >> 3, pc = idx & 7; const bf16* up = GU + (size_t)(row0 + 32 * tb + q) * D + g * 128 + ch2 * 64 + pc * 8;
            asm volatile("global_load_dwordx4 %0, %1, off" : "=v"(uv[jj]) : "v"(up)); }
        asm volatile("" ::: "memory");
        { const int itn = more ? it + G : it; GDMA(itn, bf ^ 1); }
        const int nks = 2 * tb + 2;
        f32x16 a0, a1;
#pragma unroll
        for (int i = 0; i < 16; ++i) { a0[i] = 0.f; a1[i] = 0.f; }
        const int vb = lds0 + bf * 32768 + ch2 * 1024 + v_rd_base(lane);
        const float* rsp = rsl + bf * 128 + 8 * hi;
#define KSTEP(KS) do { if (KS < nks) { const u32x4 wv = wvs[KS]; const f32x4 r0 = *(const f32x4*)(rsp + 16 * KS), r1 = *(const f32x4*)(rsp + 16 * KS + 4); \
            u32x4 av; av.x = cvt_pk_bf16(bflo(wv.x) * r0.x, bfhi(wv.x) * r0.y); av.y = cvt_pk_bf16(bflo(wv.y) * r0.z, bfhi(wv.y) * r0.w); \
            av.z = cvt_pk_bf16(bflo(wv.z) * r1.x, bfhi(wv.z) * r1.y); av.w = cvt_pk_bf16(bflo(wv.w) * r1.z, bfhi(wv.w) * r1.w); \
            kstep<KS>(a0, a1, vb, *reinterpret_cast<bf16x8*>(&av), nks); } } while (0)
        KSTEP(0); KSTEP(1); KSTEP(2); KSTEP(3); KSTEP(4); KSTEP(5); KSTEP(6); KSTEP(7);
#undef KSTEP
#pragma unroll
        for (int i4 = 0; i4 < 4; ++i4)
#pragma unroll
            for (int e = 0; e < 4; ++e) { const int i = 4 * i4 + e, q = crow(i, hi); ot[q * 68 + r32] = a0[i] * gn0 + bs4[i4][e]; ot[q * 68 + 32 + r32] = a1[i] * gn1 + bs4[i4][e]; }
        asm volatile("s_waitcnt lgkmcnt(0)" ::: "memory");
        asm volatile("s_waitcnt vmcnt(4)" : "+v"(uv[0]), "+v"(uv[1]), "+v"(uv[2]), "+v"(uv[3]), "+v"(vn0), "+v"(vn1), "+v"(vn2), "+v"(vn3) :: "memory");
        if (more && tid < 128) rsl[(bf ^ 1) * 128 + tid] = 1.0f / sqrtf(((vn0 + vn1) + (vn2 + vn3)) * (1.0f / D) + EPS);
#pragma unroll
        for (int jj = 0; jj < 4; ++jj) { const int idx = jj * 64 + lane, q = idx >> 3, pc = idx & 7;
            const f32x4 m0 = *(const f32x4*)(ot + q * 68 + pc * 8), m1 = *(const f32x4*)(ot + q * 68 + pc * 8 + 4);
            const u32x4 u_ = uv[jj];
            const f32x4 ua = gelu4((f32x4){bflo(u_.x), bfhi(u_.x), bflo(u_.y), bfhi(u_.y)}) * m0, ub = gelu4((f32x4){bflo(u_.z), bfhi(u_.z), bflo(u_.w), bfhi(u_.w)}) * m1;
            u32x4 w; w.x = cvt_pk_bf16(ua.x, ua.y); w.y = cvt_pk_bf16(ua.z, ua.w); w.z = cvt_pk_bf16(ub.x, ub.y); w.w = cvt_pk_bf16(ub.z, ub.w);
            wout[jj] = w; }
        row0_prev = row0; g_prev = g;
        asm volatile("s_waitcnt lgkmcnt(0)" ::: "memory");
    }
    if (row0_prev >= 0) SGSTORE();
#undef SGSTORE
#undef GDMA
    __syncthreads();
}
}

#define XB_TMO      128
#define XB_XCNT(j)  (256  + 64 * (j))
#define XB_XSUB(j)  (1280 + 64 * (j))
#define XB_XGEN(j)  (2304 + 64 * (j))
#define XB_TOP      3328
#define XB_TOPGEN   3392
#define XCD_BAR_WORDS 3456
#define XB_SPIN_CAP (1u << 18)

__device__ __forceinline__ unsigned xb_ld(unsigned* p)              { return __hip_atomic_load(p, __ATOMIC_RELAXED, __HIP_MEMORY_SCOPE_AGENT); }
__device__ __forceinline__ unsigned xb_add(unsigned* p, unsigned v) { return __hip_atomic_fetch_add(p, v, __ATOMIC_RELAXED, __HIP_MEMORY_SCOPE_AGENT); }
__device__ __forceinline__ unsigned xb_xcc_id() { return (unsigned)__builtin_amdgcn_s_getreg((3 << 11) | 20) & 0xFu; }
#define XB_SPIN(cond, bar) do { unsigned _sp = 0; while (cond) { __builtin_amdgcn_s_sleep(1); \
    if ((++_sp & 255u) == 0u) { if (xb_ld(&(bar)[XB_TMO])) break; if (_sp > XB_SPIN_CAP) { atomicAdd(&(bar)[XB_TMO], 1u); break; } } } } while (0)

struct XcdBarrier {
    unsigned* bar; unsigned x;
    volatile LAS unsigned* st;
    bool w0;
};

__device__ __forceinline__ XcdBarrier xcd_barrier_post(unsigned* bar, volatile LAS unsigned* st, bool w0) {
    XcdBarrier b; b.bar = bar; b.x = xb_xcc_id(); b.st = st; b.w0 = w0;
    if (lane_id_fresh() == 0 && b.w0) (void)xb_add(&bar[XB_XCNT(b.x)], 1u);
    return b;
}
__device__ __forceinline__ void xcd_barrier_complete(unsigned* bar, unsigned x, unsigned& nloc, unsigned& nx) {
    const unsigned G = gridDim.x * gridDim.y * gridDim.z;
    unsigned sum, cnt, mine, sp = 0u;
    for (;;) {
        sum = 0u; cnt = 0u; mine = 0u;
#pragma unroll
        for (unsigned j = 0; j < 16; ++j) { const unsigned c = xb_ld(&bar[XB_XCNT(j)]); sum += c; cnt += (c > 0u) ? 1u : 0u; mine = (j == x) ? c : mine; }
        if (sum == G) break;
        __builtin_amdgcn_s_sleep(1);
        if ((++sp & 255u) == 0u) { if (xb_ld(&bar[XB_TMO])) break; if (sp > XB_SPIN_CAP) { atomicAdd(&bar[XB_TMO], 1u); break; } }
    }
    nloc = mine > 0u ? mine : 1u; nx = cnt > 0u ? cnt : 1u;
}

struct NoFill { __device__ __forceinline__ void operator()() const {} };
template <class Fill>
__device__ __forceinline__ void xcd_barrier(const XcdBarrier& b, const Fill& fill) {
    asm volatile("s_waitcnt vmcnt(0)" ::: "memory");
    __syncthreads();
    if (!b.w0) fill();
    if (lane_id_fresh() == 0 && b.w0) {
        unsigned* bar = b.bar;
        __builtin_amdgcn_s_waitcnt(0);
        unsigned nloc = b.st[0], nx = b.st[1];
        if (nloc == 0u) { xcd_barrier_complete(bar, b.x, nloc, nx); b.st[0] = nloc; b.st[1] = nx; }
        const unsigned old = xb_add(&bar[XB_XSUB(b.x)], 1u);
        const unsigned gen = old / nloc;
        if (old + 1u == (gen + 1u) * nloc) {
            __builtin_amdgcn_fence(__ATOMIC_RELEASE, "agent");
            asm volatile("s_waitcnt vmcnt(0)" ::: "memory");
            const unsigned og = xb_add(&bar[XB_TOP], 1u);
            const unsigned tg = og / nx;
            if (og + 1u == (tg + 1u) * nx) xb_add(&bar[XB_TOPGEN], 1u);
            else XB_SPIN(xb_ld(&bar[XB_TOPGEN]) == tg, bar);
            __builtin_amdgcn_fence(__ATOMIC_ACQUIRE, "agent");
            xb_add(&bar[XB_XGEN(b.x)], 1u);
            asm volatile("s_waitcnt vmcnt(0)" ::: "memory");
        } else {
            XB_SPIN(xb_ld(&bar[XB_XGEN(b.x)]) == gen, bar);
            __builtin_amdgcn_fence(__ATOMIC_ACQUIRE, "agent");
            asm volatile("s_waitcnt vmcnt(0)" ::: "memory");
        }
    }
    __syncthreads();
}


struct Ptrs {
    const float *x, *c, *w_ada, *b_ada, *g1, *w_in, *sgn, *sgu_w, *sgu_b, *qg, *kg, *wa, *wb, *wo, *g2, *w_rg, *b_rg, *w_re, *b_re, *wg, *wu, *wd;
    float* out; unsigned char* ws;
};
__device__ __forceinline__ void transpose_item(const float* W, int N, int k0, int n0, bf16* dst  , int ldd, float* scr, int lane) {
    float wv[32];
#pragma unroll
    for (int i = 0; i < 32; ++i) wv[i] = W[(size_t)(k0 + 2 * i + (lane >> 5)) * N + n0 + (lane & 31)];
#pragma unroll
    for (int i = 0; i < 32; ++i) scr[(2 * i + (lane >> 5)) * 33 + (lane & 31)] = wv[i];
    asm volatile("s_waitcnt lgkmcnt(0)" ::: "memory");
    const int c = lane & 7;
#pragma unroll
    for (int j = 0; j < 4; ++j) { const int n = (lane >> 3) + 8 * j; const float* s = scr + (8 * c) * 33 + n;
        u32x4 o; o.x = pk2(s[0 * 33], s[1 * 33]); o.y = pk2(s[2 * 33], s[3 * 33]); o.z = pk2(s[4 * 33], s[5 * 33]); o.w = pk2(s[6 * 33], s[7 * 33]);
        *(u32x4*)(dst + (size_t)n * ldd + 8 * c) = o; }
    asm volatile("s_waitcnt lgkmcnt(0)" ::: "memory");
}


__device__ __forceinline__ void p_mod(const Ptrs& P, unsigned char* lds, int bid, int G, const int TID) {
    float* sc = (float*)lds;
    float* red = sc + 1024 * 16;
    const int tid = TID, wave = tid >> 6, lane = tid & 63, col = lane & 31, kh = lane >> 5;
    float* mod = (float*)(P.ws + WS_MOD);
    if (bid >= 6144 / 32) return;
    for (int i = tid; i < 16 * 1024; i += 512) { const int b = i >> 10, k = i & 1023; const float v = P.c[i]; sc[k * 16 + b] = v / (1.0f + __expf(-v)); }
    __syncthreads();
    for (int item = bid; item < 6144 / 32; item += G) {
        const int n0 = item * 32;
        float acc[16];
#pragma unroll
        for (int b = 0; b < 16; ++b) acc[b] = 0.f;
        for (int k0 = wave * 128 + kh * 64; k0 < wave * 128 + kh * 64 + 64; k0 += 8) {
            float wv[8];
#pragma unroll
            for (int u = 0; u < 8; ++u) wv[u] = P.w_ada[(size_t)(k0 + u) * 6144 + n0 + col];
#pragma unroll
            for (int u = 0; u < 8; ++u) { const f32x4* sp = (const f32x4*)(sc + (k0 + u) * 16);
#pragma unroll
                for (int q = 0; q < 4; ++q) { const f32x4 s4 = sp[q]; acc[4 * q + 0] += s4.x * wv[u]; acc[4 * q + 1] += s4.y * wv[u]; acc[4 * q + 2] += s4.z * wv[u]; acc[4 * q + 3] += s4.w * wv[u]; } }
        }
#pragma unroll
        for (int b = 0; b < 16; ++b) { acc[b] += __shfl_xor(acc[b], 32); if (kh == 0) red[(wave * 16 + b) * 32 + col] = acc[b]; }
        __syncthreads();
        { const int b = tid >> 5, l = tid & 31; float sacc = P.b_ada[n0 + l];
#pragma unroll
            for (int w = 0; w < 8; ++w) sacc += red[(w * 16 + b) * 32 + l];
            mod[b * 6144 + n0 + l] = sacc; }
        __syncthreads();
    }
}
__device__ __forceinline__ void p_prep(const Ptrs& P, unsigned char* lds, int bid, int G, const int TID) {
    const int wave = TID >> 6, lane = TID & 63;
    float* scr = (float*)lds + wave * (64 * 33);
    const int gw = bid * 8 + wave, NGW = G * 8;
    constexpr int I_IN = (D / 64) * (INW / 32), I_SQ = (D / 64) * (D / 32);
    constexpr int NIT = I_IN + 3 * I_SQ;
    bf16* WIN = (bf16*)(P.ws + WS_WIN); bf16* WAB = (bf16*)(P.ws + WS_WAB); bf16* WO = (bf16*)(P.ws + WS_WO);
    const bool split = (G == 256) && (NIT == 192 * 8 * 2 + 64 * 8 * 4);
    const int nmine = split ? (bid < 192 ? 2 : 4) : (NIT - gw + NGW - 1) / NGW;
    const int first = split ? (bid < 192 ? gw * 2 : 192 * 8 * 2 + (gw - 192 * 8) * 4) : gw, step = split ? 1 : NGW;
    for (int n_ = 0; n_ < nmine; ++n_) { const int it = first + n_ * step; if (it >= NIT) break;
        int r = it;
        if (r < I_IN) { const int nblk = INW / 32, kb = r / nblk, nb = r % nblk; const int n0 = 32 * nb;
            const int drow = n0 < 5120 ? n0 : (n0 < 6144 ? 5120 + 256 * ((n0 - 5120) >> 7) + 2 * ((n0 - 5120) & 127) : 5120 + 256 * ((n0 - 6144) >> 7) + 2 * ((n0 - 6144) & 127) + 32);
            transpose_item(P.w_in, INW, 64 * kb, n0, WIN + (size_t)drow * D + 64 * kb, D, scr, lane); continue; } r -= I_IN;
        if (r < I_SQ) { const int nblk = D / 32, kb = r / nblk, nb = r % nblk; transpose_item(P.wa, D, 64 * kb, 32 * nb, WAB + (size_t)(32 * nb) * 2048 + 64 * kb, 2048, scr, lane); continue; } r -= I_SQ;
        if (r < I_SQ) { const int nblk = D / 32, kb = r / nblk, nb = r % nblk; transpose_item(P.wb, D, 64 * kb, 32 * nb, WAB + (size_t)(32 * nb) * 2048 + 1024 + 64 * kb, 2048, scr, lane); continue; } r -= I_SQ;
        { const int nblk = D / 32, kb = r / nblk, nb = r % nblk; transpose_item(P.wo, D, 64 * kb, 32 * nb, WO + (size_t)(32 * nb) * D + 64 * kb, D, scr, lane); }
    }
    bf16* SW = (bf16*)(P.ws + WS_SW);
    for (int i = bid * 512 + TID; i < 8 * 128 * 128; i += G * 512) { const int s = i & 127, t = (i >> 7) & 127; SW[i] = (bf16)f2bf(s <= t ? P.sgu_w[i] : 0.f); }
}
constexpr int MOE_PREP_ITEMS = NE * (2 * (D / 64) * (DE / 32) + (DE / 64) * (D / 32));
constexpr int FILL_PER_WAVE = 2, FILL_PER_SEAM = 7 * FILL_PER_WAVE, FILL_SEAMS = 4;
__device__ __forceinline__ void p_prep_moe_item(const Ptrs& P, float* scr, int r, int lane) {
    if (r >= MOE_PREP_ITEMS) return;
    constexpr int I_GU = (D / 64) * (DE / 32), I_D = (DE / 64) * (D / 32);
    bf16* WGU = (bf16*)(P.ws + WS_WGU); bf16* WDn = (bf16*)(P.ws + WS_WD);
    const int per_e = 2 * I_GU + I_D; const int e = r / per_e; r -= e * per_e;
    if (r < 2 * I_GU) { const int up = r / I_GU; r -= up * I_GU; const int nblk = DE / 32, kb = r / nblk, nb = r % nblk; const int n0 = 32 * nb;
        const int drow = 256 * (n0 >> 7) + 128 * up + (n0 & 127);
        transpose_item((up ? P.wu : P.wg) + (size_t)e * D * DE, DE, 64 * kb, n0, WGU + ((size_t)e * 1024 + drow) * D + 64 * kb, D, scr, lane); return; }
    r -= 2 * I_GU;
    { const int nblk = D / 32, kb = r / nblk, nb = r % nblk; transpose_item(P.wd + (size_t)e * DE * D, D, 64 * kb, 32 * nb, WDn + ((size_t)e * 1024 + 32 * nb) * DE + 64 * kb, DE, scr, lane); }
}
__device__ __forceinline__ void p_h(const Ptrs& P, int bid, int G, const int TID) {
    const int wave = TID >> 6, lane = TID & 63;
    const float* mod = (const float*)(P.ws + WS_MOD); bf16* Hh = (bf16*)P.out;
    for (int blk = bid; blk < T / 128; blk += G) {
        const int b = (blk * 128) >> 11; const float* shift = mod + b * 6144; const float* scale = shift + 1024;
        f32x4 cm[4], ca[4];
#pragma unroll
        for (int j = 0; j < 4; ++j) { const int col = (64 * j + lane) * 4; cm[j] = *(const f32x4*)(P.g1 + col) * (*(const f32x4*)(scale + col) + 1.0f); ca[j] = *(const f32x4*)(shift + col); }
        const int row0 = blk * 128 + wave * 16;
        f32x4 nx[2][4];
#pragma unroll
        for (int a = 0; a < 2; ++a)
#pragma unroll
            for (int j = 0; j < 4; ++j) nx[a][j] = ((const f32x4*)(P.x + (size_t)(row0 + a) * D) + lane)[64 * j];
        u32x2 wp[2][4];
#pragma unroll
        for (int a = 0; a < 2; ++a)
#pragma unroll
            for (int j = 0; j < 4; ++j) wp[a][j] = (u32x2){0u, 0u};
        for (int rr = 0; rr < 16; rr += 2) { const int row = row0 + rr;
            f32x4 v[2][4]; float ss[2];
#pragma unroll
            for (int a = 0; a < 2; ++a) { float t = 0.f;
#pragma unroll
                for (int j = 0; j < 4; ++j) { v[a][j] = nx[a][j]; t += (v[a][j].x * v[a][j].x + v[a][j].y * v[a][j].y) + (v[a][j].z * v[a][j].z + v[a][j].w * v[a][j].w); }
                ss[a] = t; }
            if (rr > 0) {
#pragma unroll
                for (int a = 0; a < 2; ++a)
#pragma unroll
                    for (int j = 0; j < 4; ++j) st8_wt(Hh, (unsigned)((row - 2 + a) * D + (64 * j + lane) * 4) * 2u, wp[a][j]); }
            if (rr + 2 < 16) {
#pragma unroll
                for (int a = 0; a < 2; ++a)
#pragma unroll
                    for (int j = 0; j < 4; ++j) nx[a][j] = ((const f32x4*)(P.x + (size_t)(row + 2 + a) * D) + lane)[64 * j]; }
#pragma unroll
            for (int a = 0; a < 2; ++a) { const float rs = __builtin_amdgcn_rsqf(wave_sum_dpp(ss[a]) * (1.0f / D) + EPS);
#pragma unroll
                for (int j = 0; j < 4; ++j) { const f32x4 o = v[a][j] * rs * cm[j] + ca[j]; wp[a][j].x = pk2(o.x, o.y); wp[a][j].y = pk2(o.z, o.w); } }
        }
#pragma unroll
        for (int a = 0; a < 2; ++a)
#pragma unroll
            for (int j = 0; j < 4; ++j) st8_wt(Hh, (unsigned)((row0 + 14 + a) * D + (64 * j + lane) * 4) * 2u, wp[a][j]);
    }
}
__device__ __forceinline__ void p_qknorm_vstat(const Ptrs& P, int bid, int G, const int TID) {
    const int wave = TID >> 6, lane = TID & 63;
    bf16* Q = (bf16*)(P.ws + WS_Q); bf16* Kb = (bf16*)(P.ws + WS_K); const bf16* GV = (const bf16*)(P.ws + WS_GV); float* vstat = (float*)(P.ws + WS_VSTAT);
    for (int it = bid * 8 + wave; it < 2 * T; it += G * 8) {
        const int row = it >> 1, isk = it & 1; bf16* p = (isk ? Kb : Q) + (size_t)row * D + lane * 16; const float* g = (isk ? P.kg : P.qg) + (lane & 7) * 16;
        u32x4 w0 = *(u32x4*)p, w1 = *(u32x4*)(p + 8);
        float v[16] = {bflo(w0.x), bfhi(w0.x), bflo(w0.y), bfhi(w0.y), bflo(w0.z), bfhi(w0.z), bflo(w0.w), bfhi(w0.w), bflo(w1.x), bfhi(w1.x), bflo(w1.y), bfhi(w1.y), bflo(w1.z), bfhi(w1.z), bflo(w1.w), bfhi(w1.w)};
        float ss = 0.f;
#pragma unroll
        for (int i = 0; i < 16; ++i) ss += v[i] * v[i];
        ss += __shfl_xor(ss, 1); ss += __shfl_xor(ss, 2); ss += __shfl_xor(ss, 4);
        const float rs = (1.0f / sqrtf(ss * (1.0f / DH) + EPS)) * (isk ? 1.0f : QSCALE);
#pragma unroll
        for (int i = 0; i < 16; ++i) v[i] = v[i] * rs * g[i];
        w0.x = pk2(v[0], v[1]); w0.y = pk2(v[2], v[3]); w0.z = pk2(v[4], v[5]); w0.w = pk2(v[6], v[7]);
        w1.x = pk2(v[8], v[9]); w1.y = pk2(v[10], v[11]); w1.z = pk2(v[12], v[13]); w1.w = pk2(v[14], v[15]);
        *(u32x4*)p = w0; *(u32x4*)(p + 8) = w1;
    }
    for (int row = bid * 8 + wave; row < T; row += G * 8) {
        const bf16* p = GV + (size_t)row * D + lane * 16;
        const u32x4 w0 = *(const u32x4*)p, w1 = *(const u32x4*)(p + 8);
        const unsigned ww[8] = {w0.x, w0.y, w0.z, w0.w, w1.x, w1.y, w1.z, w1.w};
        float ss = 0.f;
#pragma unroll
        for (int i = 0; i < 8; ++i) { const float a = bflo(ww[i]), b = bfhi(ww[i]); ss += a * a + b * b; }
        ss = wave_sum(ss);
        if (lane == 0) vstat[row] = 1.0f / sqrtf(ss * (1.0f / D) + EPS);
    }
}
__device__ __forceinline__ void p_route(const Ptrs& P, unsigned char* lds, int bid, int G, const int TID) {
    float* Wr = (float*)lds;
    int* lcnt = (int*)(Wr + 20 * 1024);
    int* gbase = lcnt + 32;
    int* dec_c = gbase + 32;
    int* dec_lp = dec_c + 128;
    float* dec_w = (float*)(dec_lp + 128);
    float* bias_l = dec_w + 256;
    const int tid = TID, wave = tid >> 6, lane = tid & 63;
    const float* mod = (const float*)(P.ws + WS_MOD); bf16* H2 = (bf16*)(P.ws + WS_H2);
    int* TOK = (int*)(P.ws + WS_TOK); float* WW = (float*)(P.ws + WS_WW);
    unsigned* cnt = (unsigned*)(P.ws + WS_CTL) + CTL_CNT;
    if (tid < 20) bias_l[tid] = tid < 4 ? P.b_rg[tid] : P.b_re[tid - 4];
    for (int i = tid; i < 5 * 1024; i += 512) { const int g5 = i >> 10, k = i & 1023;
        const f32x4 w4 = *(const f32x4*)(g5 == 0 ? P.w_rg + k * 4 : P.w_re + (size_t)(g5 - 1) * 4096 + k * 4);
        Wr[(4 * g5 + 0) * 1024 + k] = w4.x; Wr[(4 * g5 + 1) * 1024 + k] = w4.y; Wr[(4 * g5 + 2) * 1024 + k] = w4.z; Wr[(4 * g5 + 3) * 1024 + k] = w4.w; }
    for (int blk = bid; blk < T / 128; blk += G) {
        if (tid < 32) lcnt[tid] = 0;
        if (wave == 0) { const unsigned* pc = (const unsigned*)(P.ws + WS_CTL) + CW_PAN_X1 + 64 * (blk >> 1); unsigned polls = 0;
            while ((unsigned)__builtin_amdgcn_readfirstlane(__hip_atomic_load(pc, __ATOMIC_RELAXED, __HIP_MEMORY_SCOPE_AGENT)) < 32u) { if (++polls > (1u << 20)) break; __builtin_amdgcn_s_sleep(2); }
            __builtin_amdgcn_fence(__ATOMIC_ACQUIRE, "agent"); asm volatile("s_waitcnt vmcnt(0)" ::: "memory"); }
        __syncthreads();
        const int b = (blk * 128) >> 11;
        const float* shift = mod + b * 6144 + 3072; const float* scale = shift + 1024;
        f32x4 cm[4], ca[4];
#pragma unroll
        for (int j = 0; j < 4; ++j) { const int col = (64 * j + lane) * 4; cm[j] = *(const f32x4*)(P.g2 + col) * (*(const f32x4*)(scale + col) + 1.0f); ca[j] = *(const f32x4*)(shift + col); }
        f32x4 wg[4][4];
#pragma unroll
        for (int j = 0; j < 4; ++j)
#pragma unroll
            for (int q = 0; q < 4; ++q) wg[j][q] = *(const f32x4*)(Wr + q * 1024 + (64 * j + lane) * 4);
        u32x2 nx[2][4];
#pragma unroll
        for (int u = 0; u < 2; ++u) { const u32x2* xr = (const u32x2*)(P.ws + WS_X1 + (size_t)(blk * 128 + wave * 16 + u) * (D * 2)) + lane;
#pragma unroll
            for (int j = 0; j < 4; ++j) nx[u][j] = xr[64 * j]; }
        for (int rr = 0; rr < 16; rr += 2) {
            f32x4 o[2][4]; float ssq[2];
#pragma unroll
            for (int u = 0; u < 2; ++u) { float ss = 0.f;
#pragma unroll
                for (int j = 0; j < 4; ++j) { const u32x2 xw = nx[u][j]; o[u][j] = (f32x4){bflo(xw.x), bfhi(xw.x), bflo(xw.y), bfhi(xw.y)}; ss += (o[u][j].x * o[u][j].x + o[u][j].y * o[u][j].y) + (o[u][j].z * o[u][j].z + o[u][j].w * o[u][j].w); }
                ssq[u] = ss; }
            if (rr + 2 < 16) {
#pragma unroll
                for (int u = 0; u < 2; ++u) { const u32x2* xr = (const u32x2*)(P.ws + WS_X1 + (size_t)(blk * 128 + wave * 16 + rr + 2 + u) * (D * 2)) + lane;
#pragma unroll
                    for (int j = 0; j < 4; ++j) nx[u][j] = xr[64 * j]; } }
            wave_sum2(ssq[0], ssq[1]);
            f32x4 gp[2];
#pragma unroll
            for (int u = 0; u < 2; ++u) { const int row = blk * 128 + wave * 16 + rr + u; const float rs = __builtin_amdgcn_rsqf(ssq[u] * (1.0f / D) + EPS);
                f32x2 g2[4];
#pragma unroll
                for (int q = 0; q < 4; ++q) g2[q] = (f32x2){0.f, 0.f};
#pragma unroll
                for (int j = 0; j < 4; ++j) { const int col = (64 * j + lane) * 4;
                    o[u][j] = o[u][j] * rs * cm[j] + ca[j];
                    u32x2 w; w.x = pk2(o[u][j].x, o[u][j].y); w.y = pk2(o[u][j].z, o[u][j].w);
                    st8_wt(H2, (unsigned)(row * D + col) * 2u, w);
                    const f32x2 olo = {o[u][j].x, o[u][j].y}, ohi = {o[u][j].z, o[u][j].w};
#pragma unroll
                    for (int q = 0; q < 4; ++q) { const f32x4 wr = wg[j][q]; g2[q] += olo * (f32x2){wr.x, wr.y}; g2[q] += ohi * (f32x2){wr.z, wr.w}; } }
                gp[u] = (f32x4){g2[0].x + g2[0].y, g2[1].x + g2[1].y, g2[2].x + g2[2].y, g2[3].x + g2[3].y}; }
            wave_sum8(gp[0], gp[1]);
            int gtv[2]; float pgv[2]; f32x4 ep[2];
#pragma unroll
            for (int u = 0; u < 2; ++u) { float gl[4];
#pragma unroll
                for (int j = 0; j < 4; ++j) gl[j] = gp[u][j] + bias_l[j];
                int gt = 0; float gm = gl[0];
#pragma unroll
                for (int j = 1; j < 4; ++j) if (gl[j] > gm) { gm = gl[j]; gt = j; }
                float den = 0.f;
#pragma unroll
                for (int j = 0; j < 4; ++j) den += __expf(gl[j] - gm);
                gtv[u] = gt; pgv[u] = __builtin_amdgcn_rcpf(den);
                f32x2 e2[4];
#pragma unroll
                for (int q = 0; q < 4; ++q) e2[q] = (f32x2){0.f, 0.f};
                const float* We = Wr + (4 + gt * 4) * 1024;
#pragma unroll
                for (int j = 0; j < 4; ++j) { const int col = (64 * j + lane) * 4; const f32x2 olo = {o[u][j].x, o[u][j].y}, ohi = {o[u][j].z, o[u][j].w};
#pragma unroll
                    for (int q = 0; q < 4; ++q) { const f32x4 wr = *(const f32x4*)(We + q * 1024 + col); e2[q] += olo * (f32x2){wr.x, wr.y}; e2[q] += ohi * (f32x2){wr.z, wr.w}; } }
                ep[u] = (f32x4){e2[0].x + e2[0].y, e2[1].x + e2[1].y, e2[2].x + e2[2].y, e2[3].x + e2[3].y}; }
            wave_sum8(ep[0], ep[1]);
#pragma unroll
            for (int u = 0; u < 2; ++u) { const int lrow = wave * 16 + rr + u; const int gt = gtv[u]; float el[4];
#pragma unroll
                for (int e = 0; e < 4; ++e) el[e] = ep[u][e] + bias_l[4 + gt * 4 + e];
                int i0 = 0; float v0 = el[0];
#pragma unroll
                for (int e = 1; e < 4; ++e) if (el[e] > v0) { v0 = el[e]; i0 = e; }
                int i1 = -1; float v1 = -3.0e38f;
#pragma unroll
                for (int e = 0; e < 4; ++e) if (e != i0 && el[e] > v1) { v1 = el[e]; i1 = e; }
                const float e1 = __expf(v1 - v0); const float p0 = pgv[u] * __builtin_amdgcn_rcpf(1.0f + e1), p1 = p0 * e1;
                if (lane == 0) { const int ea = i0 < i1 ? i0 : i1, eb = i0 < i1 ? i1 : i0; const int pi = ea == 0 ? eb - 1 : (ea == 1 ? eb + 1 : 5); const int cl = gt * 6 + pi;
                    dec_c[lrow] = cl; dec_w[lrow * 2] = i0 < i1 ? p0 : p1; dec_w[lrow * 2 + 1] = i0 < i1 ? p1 : p0;
                    dec_lp[lrow] = atomicAdd(&lcnt[cl], 1); } }
        }
        __syncthreads();
        int t2 = tid; OPAQUE(t2);
        if (t2 < NCLS) gbase[t2] = (int)atomicAdd(&cnt[t2], (unsigned)lcnt[t2]);
        __syncthreads();
        if (t2 < 128) { const int cl = dec_c[t2], pos = gbase[cl] + dec_lp[t2]; const int tok = blk * 128 + t2;
            TOK[(size_t)cl * T + pos] = tok; WW[((size_t)cl * T + pos) * 2] = dec_w[t2 * 2]; WW[((size_t)cl * T + pos) * 2 + 1] = dec_w[t2 * 2 + 1]; }
        __syncthreads();
    }
}
struct Args { Ptrs p; int ph_lo, ph_hi; };
constexpr int N_PHASES = 9;
__global__ void __launch_bounds__(512, 2) mk_fwd(Args args) {
    extern __shared__ __attribute__((aligned(16))) unsigned char lds[];
    const Ptrs& P = args.p;
    LAS unsigned char* L = (LAS unsigned char*)lds;
    volatile LAS unsigned* MISC = (volatile LAS unsigned*)(L + LDS_MISC);
    LAS int* tb = (LAS int*)(L + LDS_MISC + 256);
    const int wid_s = __builtin_amdgcn_readfirstlane((int)threadIdx.x >> 6);
#define TIDX() ((wid_s << 6) | lane_id_fresh())
    const int G = gridDim.x, bid = blockIdx.x;
    const int vcu = (G % 8 == 0) ? (bid % 8) * (G / 8) + bid / 8 : bid;
    unsigned char* ws = P.ws;
    for (int u = TIDX(); u < (LDS_BYTES - LDS_MISC) / 4; u += 512) ((LAS unsigned*)(L + LDS_MISC))[u] = 0u;
    __syncthreads();
    XcdBarrier bar = xcd_barrier_post((unsigned*)(ws + WS_CTL) + CW_BAR, MISC + 8, wid_s == 0);
    const int lo = args.ph_lo, hi = args.ph_hi;
#define IN(k) (lo <= (k) && (k) < hi)
#define SEAM(k) do { if (IN(k) && IN((k) + 1)) xcd_barrier(bar, NoFill{}); } while (0)
#define SEAMF(k) do { if (IN(k) && IN((k) + 1)) xcd_barrier(bar, [&]() { \
          \
        _Pragma("unroll 1") for (int k_ = 0; k_ < ((k) == 0 ? 1 : FILL_PER_WAVE); ++k_) { const int slot_ = ((k) == 0 ? 0 : 7 + ((k) - 1) * FILL_PER_SEAM) + (wid_s - 1) * ((k) == 0 ? 1 : FILL_PER_WAVE) + k_; \
            p_prep_moe_item(P, (float*)lds + wid_s * (64 * 33), slot_ * G + vcu, lane_id_fresh()); } }); } while (0)
    bf16* Hh = (bf16*)P.out; bf16* GU = (bf16*)((unsigned char*)P.out + 64 * MiB); bf16* SG = Hh;
    bf16* GV = (bf16*)(ws + WS_GV); bf16* Q = (bf16*)(ws + WS_Q); bf16* Kb = (bf16*)(ws + WS_K); bf16* V = (bf16*)(ws + WS_V); bf16* SA = (bf16*)(ws + WS_SA); bf16* SB = (bf16*)(ws + WS_SB);
    bf16* MG = (bf16*)(ws + WS_MG); bf16* H2 = (bf16*)(ws + WS_H2); bf16* ACT = (bf16*)(ws + WS_ACT);
    const float* mod = (const float*)(ws + WS_MOD); const unsigned* cnt = (const unsigned*)(ws + WS_CTL) + CTL_CNT; unsigned* ctlw = (unsigned*)(ws + WS_CTL);

    if (IN(0)) { p_mod(P, lds, bid, G, TIDX()); __syncthreads(); p_prep(P, lds, bid, G, TIDX());
        if (hi - lo < N_PHASES) { for (int sl = wid_s; sl * G + vcu < MOE_PREP_ITEMS; sl += 8) p_prep_moe_item(P, (float*)lds + wid_s * (64 * 33), sl * G + vcu, lane_id_fresh()); } } SEAMF(0);
    if (IN(1)) { p_h(P, bid, G, TIDX()); } SEAMF(1);
    if (IN(2)) {
        pg8::DenseOrder S{(const char*)Hh, (const char*)Hh, (const char*)(ws + WS_WIN), (size_t)256 * D * 2, (size_t)256 * D * 2, T / 256, INW / 256, (T / 256) * (INW / 256), G, bid, nullptr, 0u, nullptr, nullptr, (((T / 256) * (INW / 256)) % G == 0) ? ((T / 256) * (INW / 256)) / G : 0};
        EpiInProj E{GU, GV, Q, Kb, V, SA, SB, P.qg, P.kg, (float*)(ws + WS_VSTAT), (LAS float*)(L + LDS_EPI)};
        pg8::gemm_phase<EpiInProj, pg8::DenseOrder, false, false>(L + LDS_STAGE, D / 64, D / 64, D, D, S, E, TIDX());
    } SEAMF(2);
    if (IN(3)) { sgu::sgu_phase(GU, GV, (const float*)(ws + WS_VSTAT), P.sgn, (const bf16*)(ws + WS_SW), P.sgu_b, SG, lds, vcu, G, TIDX()); att::attn_phase(Kb, V, Q, P.qg, P.kg, lds, vcu, G, TIDX()); } SEAMF(3);
    if (IN(3) && IN(4)) { for (int sl = 7 + 3 * FILL_PER_SEAM + wid_s; sl * G + vcu < MOE_PREP_ITEMS; sl += 8) p_prep_moe_item(P, (float*)lds + wid_s * (64 * 33), sl * G + vcu, lane_id_fresh()); __syncthreads(); }
    if (IN(4)) {
        pg8::DenseOrder S{(const char*)SG, (const char*)Q - (size_t)16 * 128, (const char*)(ws + WS_WAB), (size_t)256 * D * 2, (size_t)256 * 2048 * 2, T / 256, 4, (T / 256) * 4, G, bid, nullptr, 0u, ctlw + CW_PAN_MG, nullptr};
        EpiProjAB E{SA, SB, MG};
        pg8::gemm_phase<EpiProjAB, pg8::DenseOrder, false, true>(L + LDS_STAGE, 32, 16, D, 2048, S, E, TIDX());
    }
    if (IN(5)) {
        pg8::DenseOrder S{(const char*)MG, (const char*)MG, (const char*)(ws + WS_WO), (size_t)256 * D * 2, (size_t)256 * D * 2, T / 256, 4, (T / 256) * 4, G, bid, ctlw + CW_PAN_MG, 32u, ctlw + CW_PAN_X1, ctlw + CW_BAR + XB_TMO};
        EpiOut E{P.x, mod, (bf16*)(ws + WS_X1)};
        pg8::gemm_phase<EpiOut, pg8::DenseOrder, false, false>(L + LDS_STAGE, D / 64, D / 64, D, D, S, E, TIDX());
    }
    if (IN(6)) { p_route(P, lds, bid, G, TIDX()); } SEAM(6);
    if (IN(7) || IN(8)) {
        if (TIDX() == 0) { int base = 0; for (int c = 0; c < NCLS; ++c) { tb[c] = base; base += ((int)cnt[c] + 255) >> 8; } tb[NCLS] = base; }
        __syncthreads();
    }
    if (IN(7)) {
        pg8::MoeOrder1 S{tb, cnt, (const char*)H2, (const char*)(ws + WS_WGU), (const int*)(ws + WS_TOK), G, vcu, (unsigned*)(ws + WS_CTL) + CW_TILE, (const float*)(ws + WS_WW), L, 0};
        EpiMoe1 E{ACT, L, 0};
        pg8::gemm_phase<EpiMoe1, pg8::MoeOrder1, true, false>(L + LDS_STAGE, D / 64, D / 64, D, D, S, E, TIDX());
    }
    if (IN(8)) {
        pg8::MoeOrder2 S{tb, cnt, (const char*)ACT, (const char*)(ws + WS_WD), (const int*)(ws + WS_TOK), G, G - 1 - vcu  , (unsigned*)(ws + WS_CTL) + CW_TILE, (unsigned*)(ws + WS_CTL) + CW_BAR + XB_TMO, L, 0};
        EpiMoe2 E{P.out, mod, (const bf16*)(ws + WS_X1), L, 0};
        pg8::gemm_phase<EpiMoe2, pg8::MoeOrder2, false, false, true>(L + LDS_STAGE, 16, 8, 1024, DE, S, E, TIDX());
    }
#undef IN
#undef SEAM
#undef SEAMF
}

#ifndef MK_PER_PHASE
#define MK_PER_PHASE 0
#endif
extern "C" void kernel_launch(void* const* d_in, const int* in_sizes, int n_in, void* d_out, int out_size, void* d_ws, size_t ws_size, hipStream_t stream) {
    static int grid = 0;
    if (grid == 0) {
        if (n_in != 22 || in_sizes[0] != T * D || out_size != T * D || ws_size < WS_END) { fprintf(stderr, "kernel_launch: shape/ws mismatch n_in %d in0 %d out %d ws %zu\n", n_in, n_in > 0 ? in_sizes[0] : -1, out_size, ws_size); grid = -1; return; }
        int dev = 0, cus = 0;
        if (hipGetDevice(&dev) != hipSuccess || hipDeviceGetAttribute(&cus, hipDeviceAttributeMultiprocessorCount, dev) != hipSuccess) { grid = -1; return; }
        if (hipFuncSetAttribute((const void*)mk_fwd, hipFuncAttributeMaxDynamicSharedMemorySize, LDS_BYTES) != hipSuccess) { fprintf(stderr, "kernel_launch: hipFuncSetAttribute failed\n"); grid = -1; return; }
        grid = cus;
    }
    if (grid < 0) return;
    (void)hipMemsetAsync((char*)d_ws + WS_CTL, 0, 256 * 1024, stream);
    Args a{};
    const float** pp = (const float**)&a.p;
    for (int i = 0; i < 22; ++i) pp[i] = (const float*)d_in[i];
    a.p.out = (float*)d_out; a.p.ws = (unsigned char*)d_ws;
#if MK_PER_PHASE
    for (int k = 0; k < N_PHASES; ++k) { a.ph_lo = k; a.ph_hi = k + 1; hipLaunchKernelGGL(mk_fwd, dim3(grid), dim3(512), LDS_BYTES, stream, a); }
#else
    a.ph_lo = 0; a.ph_hi = N_PHASES;
    hipLaunchKernelGGL(mk_fwd, dim3(grid), dim3(512), LDS_BYTES, stream, a);
#endif
}
```
